# Optimizing an MI355X kernel written in HIP

```python
import math
import jax, jax.numpy as jnp
from jax import lax
import numpy as np

D_MODEL = 1024
BATCH = 8
SEQ = 4096
DEPTH = 2

LRU_WIDTH = D_MODEL
LRU_BLOCKS = 4
LRU_BLOCK_W = LRU_WIDTH // LRU_BLOCKS
RG_LRU_C = 8.0
CONV_WIDTH = 4
CONV_PAD_LEFT = 2
CONV_PAD_RIGHT = CONV_WIDTH - 1 - CONV_PAD_LEFT

RET_HEADS = 4
RET_QK_DIM = D_MODEL
RET_V_DIM = 2 * D_MODEL
RET_HEAD_QK = RET_QK_DIM // RET_HEADS
RET_HEAD_V = RET_V_DIM // RET_HEADS
RET_CHUNK = 128
ROPE_BASE = 10000.0

FFN_HIDDEN = ((8 * D_MODEL // 3 + 255) // 256) * 256

NORM_EPS = 1e-6
N_LRU_LAYERS = (DEPTH + 1) // 2
N_RET_LAYERS = DEPTH // 2

kernel_name = "bidir_hybrid_rglru_retention_swiglu"


def rms_norm(x, g):
    xf = x.astype(jnp.float32)
    y = xf * lax.rsqrt(jnp.mean(xf * xf, axis=-1, keepdims=True) + NORM_EPS)
    return (y * g.astype(jnp.float32)).astype(x.dtype)


def _linear_scan_combine(left, right):
    a1, b1 = left
    a2, b2 = right
    return a1 * a2, a2 * b1 + b2


def rg_lru_mixer(h, w_in, conv_w, conv_b, ga_w, ga_b, gx_w, gx_b, lam, w_out):
    b, s, _ = h.shape
    u = h @ w_in
    xb, gb = jnp.split(u, 2, axis=-1)
    xb = lax.conv_general_dilated(
        xb, conv_w[:, None, :].astype(xb.dtype), window_strides=(1,),
        padding=[(CONV_PAD_LEFT, CONV_PAD_RIGHT)],
        dimension_numbers=("NWC", "WIO", "NWC"),
        feature_group_count=LRU_WIDTH) + conv_b
    xg = xb.reshape(b, s, LRU_BLOCKS, LRU_BLOCK_W)
    h_sum = jnp.zeros((b, s, LRU_WIDTH), jnp.float32)
    for d in range(2):
        r = jax.nn.sigmoid(
            jnp.einsum("bsnk,nkj->bsnj", xg, ga_w[d]).reshape(b, s, LRU_WIDTH) + ga_b[d])
        i = jax.nn.sigmoid(
            jnp.einsum("bsnk,nkj->bsnj", xg, gx_w[d]).reshape(b, s, LRU_WIDTH) + gx_b[d])
        log_a = (-RG_LRU_C * r.astype(jnp.float32)) * jax.nn.softplus(-lam[d].astype(jnp.float32))
        a = jnp.exp(log_a)
        inp = jnp.sqrt(-jnp.expm1(2.0 * log_a)) * (i * xb).astype(jnp.float32)
        if d == 1:
            a, inp = jnp.flip(a, axis=1), jnp.flip(inp, axis=1)
        _, hs = lax.associative_scan(_linear_scan_combine, (a, inp), axis=1)
        if d == 1:
            hs = jnp.flip(hs, axis=1)
        h_sum = h_sum + hs
    y = h_sum.astype(h.dtype) * jax.nn.gelu(gb, approximate=True)
    return y @ w_out


def apply_rotary(x):
    s, d = x.shape[1], x.shape[-1]
    half = d // 2
    inv_freq = 1.0 / (ROPE_BASE ** jnp.linspace(0.0, 1.0, half, dtype=jnp.float32))
    ang = jnp.arange(s, dtype=jnp.float32)[:, None] * inv_freq[None, :]
    cos = jnp.cos(ang)[None, :, None, :].astype(x.dtype)
    sin = jnp.sin(ang)[None, :, None, :].astype(x.dtype)
    x1, x2 = x[..., :half], x[..., half:]
    return jnp.concatenate([x1 * cos - x2 * sin, x2 * cos + x1 * sin], axis=-1)


def chunk_retention(q, k, v, log_g, strict):
    b, nh, s, dk = q.shape
    dv = v.shape[-1]
    nc = s // RET_CHUNK
    qc = q.reshape(b, nh, nc, RET_CHUNK, dk)
    kc = k.reshape(b, nh, nc, RET_CHUNK, dk)
    vc = v.reshape(b, nh, nc, RET_CHUNK, dv)
    pos = jnp.arange(RET_CHUNK, dtype=jnp.float32)
    diff = pos[:, None] - pos[None, :]
    mask = diff > 0 if strict else diff >= 0
    dec = jnp.where(mask[None], jnp.exp(jnp.where(mask, diff, 0.0)[None] * log_g[:, None, None]), 0.0)
    scores = jnp.einsum("bhnid,bhnjd->bhnij", qc, kc) * dec[None, :, None].astype(q.dtype)
    y_intra = jnp.einsum("bhnij,bhnje->bhnie", scores, vc)
    zeta = jnp.exp((RET_CHUNK - 1.0 - pos)[None, :] * log_g[:, None]).astype(q.dtype)
    xi = jnp.exp((pos + 1.0)[None, :] * log_g[:, None]).astype(q.dtype)
    g_chunk = jnp.exp(RET_CHUNK * log_g).astype(q.dtype)

    def step(state, inp):
        q_n, k_n, v_n = inp
        y = jnp.einsum("bhid,bhde->bhie", q_n, state) * xi[None, :, :, None]
        state = state * g_chunk[None, :, None, None] + jnp.einsum(
            "bhjd,bhje->bhde", k_n * zeta[None, :, :, None], v_n)
        return state, y

    state0 = jnp.zeros((b, nh, dk, dv), q.dtype)
    xs = (jnp.moveaxis(qc, 2, 0), jnp.moveaxis(kc, 2, 0), jnp.moveaxis(vc, 2, 0))
    _, ys = lax.scan(step, state0, xs)
    y = y_intra + jnp.moveaxis(ys, 0, 2).astype(y_intra.dtype)
    return y.reshape(b, nh, s, dv)


def retention_mixer(h, w_in, w_out):
    b, s, _ = h.shape
    u = h @ w_in
    q, k, v, gate = jnp.split(u, [RET_QK_DIM, 2 * RET_QK_DIM, 2 * RET_QK_DIM + RET_V_DIM], axis=-1)
    q = apply_rotary(q.reshape(b, s, RET_HEADS, RET_HEAD_QK))
    k = apply_rotary(k.reshape(b, s, RET_HEADS, RET_HEAD_QK)) * (RET_HEAD_QK ** -0.5)
    v = v.reshape(b, s, RET_HEADS, RET_HEAD_V)
    q, k, v = (jnp.transpose(t, (0, 2, 1, 3)) for t in (q, k, v))
    log_g_fwd = jnp.log1p(-jnp.exp2(-5.0 - jnp.arange(RET_HEADS, dtype=jnp.float32)))
    log_g_bwd = log_g_fwd[::-1]
    y_f = chunk_retention(q, k, v, log_g_fwd, strict=False)
    y_b = jnp.flip(chunk_retention(jnp.flip(q, 2), jnp.flip(k, 2), jnp.flip(v, 2),
                                   log_g_bwd, strict=True), 2)
    y = (y_f + y_b).astype(jnp.float32)
    y = y * lax.rsqrt(jnp.mean(y * y, axis=-1, keepdims=True) + NORM_EPS)
    y = jnp.transpose(y, (0, 2, 1, 3)).reshape(b, s, RET_V_DIM).astype(h.dtype)
    return (y * jax.nn.silu(gate)) @ w_out


def swiglu_ffn(h, w_gate, w_up, w_down):
    return (jax.nn.silu(h @ w_gate) * (h @ w_up)) @ w_down


def setup_inputs(seed: int = 0) -> dict:
    key = jax.random.key(seed)
    ks = iter(jax.random.split(key, 32))
    f32 = jnp.float32

    def nrm(shape, fan_in):
        return jax.random.normal(next(ks), shape, f32) * (fan_in ** -0.5)

    def small(shape):
        return 0.01 * jax.random.normal(next(ks), shape, f32)

    a_c = jax.random.uniform(next(ks), (N_LRU_LAYERS, 2, LRU_WIDTH), f32, 0.9, 0.999)
    sig = a_c ** (1.0 / RG_LRU_C)
    lam = jnp.log(sig) - jnp.log1p(-sig)
    return {
        "x": jax.random.normal(next(ks), (BATCH, SEQ, D_MODEL), f32),
        "ln_mix": 1.0 + small((DEPTH, D_MODEL)),
        "ln_ffn": 1.0 + small((DEPTH, D_MODEL)),
        "ln_final": 1.0 + small((D_MODEL,)),
        "lru_w_in": nrm((N_LRU_LAYERS, D_MODEL, 2 * LRU_WIDTH), D_MODEL),
        "lru_conv_w": nrm((N_LRU_LAYERS, CONV_WIDTH, LRU_WIDTH), CONV_WIDTH),
        "lru_conv_b": small((N_LRU_LAYERS, LRU_WIDTH)),
        "lru_gate_a_w": nrm((N_LRU_LAYERS, 2, LRU_BLOCKS, LRU_BLOCK_W, LRU_BLOCK_W), LRU_BLOCK_W),
        "lru_gate_a_b": small((N_LRU_LAYERS, 2, LRU_WIDTH)),
        "lru_gate_x_w": nrm((N_LRU_LAYERS, 2, LRU_BLOCKS, LRU_BLOCK_W, LRU_BLOCK_W), LRU_BLOCK_W),
        "lru_gate_x_b": small((N_LRU_LAYERS, 2, LRU_WIDTH)),
        "lru_lambda": lam,
        "lru_w_out": nrm((N_LRU_LAYERS, LRU_WIDTH, D_MODEL), LRU_WIDTH),
        "ret_w_in": nrm((N_RET_LAYERS, D_MODEL, 2 * RET_QK_DIM + 2 * RET_V_DIM), D_MODEL),
        "ret_w_out": nrm((N_RET_LAYERS, RET_V_DIM, D_MODEL), RET_V_DIM),
        "ffn_w_gate": nrm((DEPTH, D_MODEL, FFN_HIDDEN), D_MODEL),
        "ffn_w_up": nrm((DEPTH, D_MODEL, FFN_HIDDEN), D_MODEL),
        "ffn_w_down": nrm((DEPTH, FFN_HIDDEN, D_MODEL), FFN_HIDDEN),
    }


def reference(x, ln_mix, ln_ffn, ln_final, lru_w_in, lru_conv_w, lru_conv_b,
              lru_gate_a_w, lru_gate_a_b, lru_gate_x_w, lru_gate_x_b, lru_lambda,
              lru_w_out, ret_w_in, ret_w_out, ffn_w_gate, ffn_w_up, ffn_w_down):
    h = x
    for layer in range(DEPTH):
        j = layer // 2
        hn = rms_norm(h, ln_mix[layer])
        if layer % 2 == 0:
            mix = rg_lru_mixer(hn, lru_w_in[j], lru_conv_w[j], lru_conv_b[j],
                               lru_gate_a_w[j], lru_gate_a_b[j], lru_gate_x_w[j],
                               lru_gate_x_b[j], lru_lambda[j], lru_w_out[j])
        else:
            mix = retention_mixer(hn, ret_w_in[j], ret_w_out[j])
        h = h + mix.astype(h.dtype)
        h = h + swiglu_ffn(rms_norm(h, ln_ffn[layer]), ffn_w_gate[layer],
                           ffn_w_up[layer], ffn_w_down[layer]).astype(h.dtype)
    return rms_norm(h, ln_final)
```

```cpp
#include <hip/hip_runtime.h>
#include <hip/hip_cooperative_groups.h>
#include <cstdio>
#include <cstdint>
namespace cg = cooperative_groups;

#define LAS __attribute__((address_space(3)))
typedef unsigned short bf16_t;
typedef short bf16x8 __attribute__((ext_vector_type(8)));
typedef float f32x4 __attribute__((ext_vector_type(4)));
typedef unsigned u32x4 __attribute__((ext_vector_type(4)));
typedef _Float16 half2_t __attribute__((ext_vector_type(2)));

constexpr int T = 32768, D = 1024, SEQ = 4096, FF = 2816, NGRP = 4, TG = 8192;
constexpr float EPS = 1e-6f;
constexpr size_t MiB = 1u << 20;
constexpr size_t WS_SS1 = 484 * MiB, WS_SS2 = 486 * MiB, WS_SS3 = 488 * MiB, WS_SS4 = 490 * MiB, WS_YSS = 492 * MiB;
constexpr size_t WS_RQ = 0;
constexpr size_t WS_COST = 1 * MiB, WS_SINT = 3 * MiB, WS_COSJ = 5 * MiB, WS_SINJ = 7 * MiB, WS_CLA = 9 * MiB;
constexpr size_t WS_WIN = 10 * MiB, WS_WGA = 14 * MiB, WS_WGX = 15 * MiB, WS_WLO = 16 * MiB, WS_WFG = 18 * MiB, WS_WFU = 29 * MiB,
                 WS_WFD = 40 * MiB, WS_WRI = 51 * MiB, WS_WRO = 63 * MiB;
constexpr size_t WS_XN = 68 * MiB;
constexpr size_t WS_XBP = 132 * MiB, WS_GG = 196 * MiB, WS_XB = 260 * MiB, WS_LAF = 68 * MiB, WS_INF = 132 * MiB, WS_LAB = 324 * MiB,
                 WS_INB = 388 * MiB, WS_YL = 260 * MiB;
constexpr size_t WS_ACT = 132 * MiB;
constexpr size_t WS_YZ = 132 * MiB, WS_A2 = 260 * MiB, WS_KB = 308 * MiB, WS_KTF = 324 * MiB, WS_KTB = 340 * MiB, WS_BT2 = 356 * MiB,
                 WS_SG = 452 * MiB, WS_END = 496 * MiB;
constexpr int LDS_BYTES = 147456;

__device__ __forceinline__ float l2gam(int h) {
    return h == 0 ? -0.04580368961312479f : (h == 1 ? -0.02272007650008353f : (h == 2 ? -0.011315313227834146f : -0.005646563141142063f));
}
__device__ __forceinline__ float ex2(float x) { return __builtin_amdgcn_exp2f(x); }
__device__ __forceinline__ float rcpf_(float x) { return __builtin_amdgcn_rcpf(x); }
__device__ __forceinline__ float sigm(float x) { return rcpf_(1.0f + ex2(-1.4426950408889634f * x)); }
__device__ __forceinline__ float rsq(float x) { return __builtin_amdgcn_rsqf(x); }
__device__ __forceinline__ unsigned cvt_pk_bf16(float lo, float hi) { unsigned r; asm volatile("v_cvt_pk_bf16_f32 %0, %1, %2" : "=v"(r) : "v"(lo), "v"(hi)); return r; }
__device__ __forceinline__ u32x4 pack8(f32x4 a, f32x4 b) { u32x4 w; w.x = cvt_pk_bf16(a[0], a[1]); w.y = cvt_pk_bf16(a[2], a[3]); w.z = cvt_pk_bf16(b[0], b[1]); w.w = cvt_pk_bf16(b[2], b[3]); return w; }
__device__ __forceinline__ f32x4 unlo(u32x4 w) { f32x4 r; r[0] = __uint_as_float(w.x << 16); r[1] = __uint_as_float(w.x & 0xffff0000u); r[2] = __uint_as_float(w.y << 16); r[3] = __uint_as_float(w.y & 0xffff0000u); return r; }
__device__ __forceinline__ f32x4 unhi(u32x4 w) { f32x4 r; r[0] = __uint_as_float(w.z << 16); r[1] = __uint_as_float(w.z & 0xffff0000u); r[2] = __uint_as_float(w.w << 16); r[3] = __uint_as_float(w.w & 0xffff0000u); return r; }
__device__ __forceinline__ unsigned pkh(float lo, float hi) { half2_t h; h.x = (_Float16)lo; h.y = (_Float16)hi; return __builtin_bit_cast(unsigned, h); }
__device__ __forceinline__ u32x4 pack8h(f32x4 a, f32x4 b) { u32x4 w; w.x = pkh(a[0], a[1]); w.y = pkh(a[2], a[3]); w.z = pkh(b[0], b[1]); w.w = pkh(b[2], b[3]); return w; }
__device__ __forceinline__ float h2f_lo(unsigned w) { return (float)__builtin_bit_cast(_Float16, (unsigned short)(w & 0xffffu)); }
__device__ __forceinline__ float h2f_hi(unsigned w) { return (float)__builtin_bit_cast(_Float16, (unsigned short)(w >> 16)); }
__device__ __forceinline__ f32x4 unlo_h(u32x4 w) { const unsigned a = w.x, b = w.y; f32x4 r; r[0] = h2f_lo(a); r[1] = h2f_hi(a); r[2] = h2f_lo(b); r[3] = h2f_hi(b); return r; }
__device__ __forceinline__ f32x4 unhi_h(u32x4 w) { const unsigned a = w.z, b = w.w; f32x4 r; r[0] = h2f_lo(a); r[1] = h2f_hi(a); r[2] = h2f_lo(b); r[3] = h2f_hi(b); return r; }
__device__ __forceinline__ f32x4 ex2v(f32x4 v) { f32x4 r; r[0] = ex2(v[0]); r[1] = ex2(v[1]); r[2] = ex2(v[2]); r[3] = ex2(v[3]); return r; }
__device__ __forceinline__ f32x4 sigv(f32x4 v) { f32x4 r; r[0] = sigm(v[0]); r[1] = sigm(v[1]); r[2] = sigm(v[2]); r[3] = sigm(v[3]); return r; }
__device__ __forceinline__ f32x4 geluv(f32x4 x) {
    f32x4 r;
#pragma unroll
    for (int i = 0; i < 4; ++i) { const float v = x[i], u = 0.7978845608028654f * (v + 0.044715f * v * v * v); r[i] = v * rcpf_(1.0f + ex2(-2.8853900817779268f * u)); }
    return r;
}

__device__ __forceinline__ void lru_step(float l, float q, float& H) { const float a = ex2(l); H = a * H + __builtin_amdgcn_sqrtf(fmaxf(1.0f - a * a, 0.f)) * q; }
__device__ __forceinline__ float sum16(const float* p) { const f32x4 a = *(const f32x4*)p, b = *(const f32x4*)(p + 4), c = *(const f32x4*)(p + 8), d = *(const f32x4*)(p + 12);
    const f32x4 s = (a + b) + (c + d); return (s[0] + s[1]) + (s[2] + s[3]); }
__device__ __forceinline__ float row_rs(const float* ssp, int row) { return rsq(sum16(ssp + (size_t)row * 16) * (1.0f / 1024.0f) + EPS); }
namespace pg8 {
constexpr int BM = 256, BK = 64, HALF = 128, HTB = HALF * BK * 2, STAGE_BYTES = 8 * HTB;
__device__ __forceinline__ int lds_byte(int r, int c) { const int st = (r >> 4) * 2 + (c >> 5), rr = r & 15, cc = c & 31, ob = rr * 64 + cc * 2; return st * 1024 + (ob ^ (((ob >> 9) & 1) << 5)); }
__device__ __forceinline__ void stage_rc(int b, int& R, int& C) { const int st = b / 1024, sb = b % 1024, swz = sb ^ (((sb >> 9) & 1) << 5); R = (st >> 1) * 16 + swz / 64; C = (st & 1) * 32 + (swz % 64) / 2; }
__device__ __forceinline__ int perm32(int rho) { const int n = rho >> 4, i = rho & 15; return 8 * (i >> 2) + 4 * n + (i & 3); }
struct Unit { const char *a0, *a1, *b0, *b1; int pm, pn, z; };

struct NoHook { static constexpr bool ON = false; };
struct HeadRescale { static constexpr bool ON = true; const float* rq; };
template <class Epi, class Sched, class Hook = NoHook>
__device__ __forceinline__ void gemm_phase(LAS unsigned char* lds, const int lda, const int ldb, const int K, const Sched& S, const Epi& E, const Hook HK = Hook()) {
    int tid = threadIdx.x; asm volatile("" : "+v"(tid));
    const int wid = __builtin_amdgcn_readfirstlane(tid >> 6), lane = tid & 63, wr = wid >> 2, wc = wid & 3, fr = lane & 15, fq = lane >> 4;
    const int nt = K / BK;
    unsigned voffA[2], voffB[2];
#pragma unroll
    for (int i = 0; i < 2; ++i) { int R, C; stage_rc(tid * 16 + i * 8192, R, C); const int Rb = (R & ~31) + perm32(R & 31);
        voffA[i] = (unsigned)(R * lda + C) * 2u; voffB[i] = (unsigned)(Rb * ldb + C) * 2u; }
    const size_t kstep = (size_t)(BK * 2);
    const unsigned ldsw = (unsigned)wid * 1024u;
    const int aoff = lds_byte(wr * 64 + fr, fq * 8), boff = lds_byte(wc * 32 + fr, fq * 8);
#define PG8_SA(b, h) (((b) * 2 + (h)) * HTB)
#define PG8_SB(b, h) ((4 + (b) * 2 + (h)) * HTB)
#define PG8_STAGE(bufoff, gbase, voff) do { _Pragma("unroll") for (int _i = 0; _i < 2; ++_i) \
        __builtin_amdgcn_global_load_lds((const unsigned*)((const char*)(gbase) + (voff)[_i]), (LAS unsigned*)(lds + (bufoff) + ldsw + _i * 8192), 16, 0, 0); } while (0)
#define PG8_LDA(dst, b, h) do { _Pragma("unroll") for (int m = 0; m < 4; ++m) _Pragma("unroll") for (int k = 0; k < 2; ++k) dst[m][k] = *(const LAS bf16x8*)(lds + PG8_SA(b, h) + aoff + m * 2048 + k * 1024); } while (0)
#define PG8_LDB(dst, b, h) do { _Pragma("unroll") for (int n = 0; n < 2; ++n) _Pragma("unroll") for (int k = 0; k < 2; ++k) dst[n][k] = *(const LAS bf16x8*)(lds + PG8_SB(b, h) + boff + n * 2048 + k * 1024); } while (0)
#define PG8_MMA(ai, bj, At, Bt) do { __builtin_amdgcn_s_setprio(1); _Pragma("unroll") for (int m = 0; m < 4; ++m) _Pragma("unroll") for (int n = 0; n < 2; ++n) _Pragma("unroll") for (int k = 0; k < 2; ++k) \
        acc[ai][bj][m][n] = __builtin_amdgcn_mfma_f32_16x16x32_bf16(Bt[n][k], At[m][k], acc[ai][bj][m][n], 0, 0, 0); __builtin_amdgcn_s_setprio(0); } while (0)
#define PG8_WAIT_V(n) asm volatile("s_waitcnt vmcnt(" #n ")" ::: "memory")
#define PG8_WAIT_L(n) asm volatile("s_waitcnt lgkmcnt(" #n ")" ::: "memory")
#define PG8_BAR __builtin_amdgcn_s_barrier()
#define PG8_SCHED __builtin_amdgcn_sched_barrier(0)
    Unit cur, nxt; int ui = 0;
    if (!S.next(0, cur)) return;
#define PG8_OPAQUE(u) asm volatile("" : "+s"((u).a0), "+s"((u).a1), "+s"((u).b0), "+s"((u).b1))
    PG8_OPAQUE(cur);
    f32x4 acc[2][2][4][2];
#pragma unroll
    for (int a = 0; a < 2; ++a)
#pragma unroll
        for (int b = 0; b < 2; ++b)
#pragma unroll
            for (int m = 0; m < 4; ++m)
#pragma unroll
                for (int n = 0; n < 2; ++n) acc[a][b][m][n] = (f32x4){0.f, 0.f, 0.f, 0.f};
    bf16x8 At[4][2], B0[2][2], B1[2][2];
    float hkr[8] = {1.f, 1.f, 1.f, 1.f, 1.f, 1.f, 1.f, 1.f}; (void)hkr;
    const char *cA0 = cur.a0, *cA1 = cur.a1, *cB0 = cur.b0, *cB1 = cur.b1;
    PG8_STAGE(PG8_SB(0, 0), cB0, voffB); PG8_STAGE(PG8_SB(0, 1), cB1, voffB); PG8_STAGE(PG8_SA(0, 0), cA0, voffA); PG8_STAGE(PG8_SA(0, 1), cA1, voffA);
    if (wr == 1) PG8_BAR;
    PG8_WAIT_V(2); PG8_BAR;
    PG8_STAGE(PG8_SB(1, 0), cB0 + kstep, voffB); PG8_STAGE(PG8_SA(1, 0), cA0 + kstep, voffA); PG8_STAGE(PG8_SB(1, 1), cB1 + kstep, voffB);
    PG8_WAIT_V(6); PG8_BAR;
    for (;;) {
        const bool has_next = S.next(ui + 1, nxt);
        if (has_next) PG8_OPAQUE(nxt);
        const char *nA0 = has_next ? nxt.a0 : cA0, *nA1 = has_next ? nxt.a1 : cA1, *nB0 = has_next ? nxt.b0 : cB0, *nB1 = has_next ? nxt.b1 : cB1;
#pragma unroll 1
        for (int t = 0; t < nt; t += 2) {
            const bool last = (t == nt - 2);
            bool hk = false;
            if constexpr (Hook::ON) { hk = (((t + 2) & 7) == 0) && (t + 2 < nt);
                if (hk) { const int hd = ((t + 2) >> 3) - 1;
                    int frh = fr; asm volatile("" : "+v"(frh));
#pragma unroll
                    for (int ai = 0; ai < 2; ++ai)
#pragma unroll
                        for (int m = 0; m < 4; ++m) hkr[ai * 4 + m] = HK.rq[(size_t)(cur.pm * 256 + ai * 128 + wr * 64 + m * 16 + frh) * 4 + hd]; } }
            const char* a1_1 = cA1 + (size_t)(t + 1) * kstep;
            const char* a2_0 = last ? nA0 : cA0 + (size_t)(t + 2) * kstep; const char* a2_1 = last ? nA1 : cA1 + (size_t)(t + 2) * kstep;
            const char* b2_0 = last ? nB0 : cB0 + (size_t)(t + 2) * kstep; const char* b2_1 = last ? nB1 : cB1 + (size_t)(t + 2) * kstep;
            const char* a3_0 = a2_0 + kstep; const char* b3_0 = b2_0 + kstep; const char* b3_1 = b2_1 + kstep;
            PG8_LDB(B0, 0, 0); PG8_LDB(B1, 0, 1); PG8_SCHED; PG8_LDA(At, 0, 0); PG8_STAGE(PG8_SA(1, 1), a1_1, voffA);
            PG8_WAIT_V(8); PG8_WAIT_L(0); PG8_BAR; PG8_MMA(0, 0, At, B0); PG8_MMA(0, 1, At, B1); PG8_BAR; PG8_SCHED;
            PG8_LDA(At, 0, 1); PG8_STAGE(PG8_SB(0, 0), b2_0, voffB); PG8_STAGE(PG8_SB(0, 1), b2_1, voffB); PG8_STAGE(PG8_SA(0, 0), a2_0, voffA);
            PG8_WAIT_V(8); PG8_WAIT_L(0); PG8_BAR; PG8_MMA(1, 0, At, B0); PG8_MMA(1, 1, At, B1); PG8_BAR; PG8_SCHED;
            PG8_LDB(B0, 1, 0); PG8_LDB(B1, 1, 1); PG8_SCHED; PG8_LDA(At, 1, 0); PG8_STAGE(PG8_SA(0, 1), a2_1, voffA);
            PG8_WAIT_V(8); PG8_WAIT_L(0); PG8_BAR; PG8_MMA(0, 0, At, B0); PG8_MMA(0, 1, At, B1); PG8_BAR; PG8_SCHED;
            PG8_LDA(At, 1, 1); PG8_STAGE(PG8_SB(1, 0), b3_0, voffB); PG8_STAGE(PG8_SB(1, 1), b3_1, voffB); PG8_STAGE(PG8_SA(1, 0), a3_0, voffA);
            PG8_WAIT_V(8); PG8_WAIT_L(0); PG8_BAR; PG8_MMA(1, 0, At, B0); PG8_MMA(1, 1, At, B1); PG8_BAR; PG8_SCHED;
            if constexpr (Hook::ON) { if (hk) {
#pragma unroll
                for (int ai = 0; ai < 2; ++ai)
#pragma unroll
                    for (int bj = 0; bj < 2; ++bj)
#pragma unroll
                        for (int m = 0; m < 4; ++m)
#pragma unroll
                            for (int n = 0; n < 2; ++n) acc[ai][bj][m][n] = acc[ai][bj][m][n] * hkr[ai * 4 + m]; } }
        }
        if (wr == 0) PG8_BAR;
        { int fr_ = fr, fq_ = fq; asm volatile("" : "+v"(fr_), "+v"(fq_)); E(acc, cur, wr, wc, fr_, fq_); }
        if (!has_next) break;
#pragma unroll
        for (int a = 0; a < 2; ++a)
#pragma unroll
            for (int b = 0; b < 2; ++b)
#pragma unroll
                for (int m = 0; m < 4; ++m)
#pragma unroll
                    for (int n = 0; n < 2; ++n) acc[a][b][m][n] = (f32x4){0.f, 0.f, 0.f, 0.f};
        cur = nxt; cA0 = nA0; cA1 = nA1; cB0 = nB0; cB1 = nB1; ++ui;
        if (wr == 1) PG8_BAR;
    }
    PG8_WAIT_V(0);
    PG8_BAR;
#undef PG8_OPAQUE
#undef PG8_SA
#undef PG8_SB
#undef PG8_STAGE
#undef PG8_LDA
#undef PG8_LDB
#undef PG8_MMA
#undef PG8_WAIT_V
#undef PG8_WAIT_L
#undef PG8_BAR
#undef PG8_SCHED
}
}
using pg8::Unit;
typedef const f32x4 (&AccRef)[2][2][4][2];

__device__ __forceinline__ bool order2d(int i, int G, int c, int nM, int nN, int& pm, int& pn) {
    const int nwg = nM * nN; const long L = (long)i * G + c; if (L >= nwg) return false;
    int wgid = (int)L; { const int q = nwg / 8, r = nwg % 8, xcd = wgid % 8, off = wgid / 8; wgid = (xcd < r ? xcd * (q + 1) : r * (q + 1) + (xcd - r) * q) + off; }
    const int nig = 8 * nN, gid = wgid / nig, fm = gid * 8, gsz = (nM - fm) < 8 ? (nM - fm) : 8;
    pm = fm + ((wgid % nig) % gsz); pn = (wgid % nig) / gsz; return true;
}
struct StdSched {
    const char *A, *B; int nM, nN, lda, ldb, G, c;
    __device__ __forceinline__ bool next(int i, Unit& u) const {
        int pm, pn; if (!order2d(i, G, c, nM, nN, pm, pn)) return false;
        u.pm = pm; u.pn = pn; u.z = 0; u.a0 = A + (size_t)pm * 256 * lda * 2; u.a1 = u.a0 + (size_t)128 * lda * 2; u.b0 = B + (size_t)pn * 256 * ldb * 2; u.b1 = u.b0 + (size_t)128 * ldb * 2; return true; }
};
__device__ __forceinline__ void order2d_L(int L, int nM, int nN, int& pm, int& pn) {
    const int nwg = nM * nN, q = nwg / 8, xcd = L % 8, off = L / 8; const int wgid = xcd * q + off;
    const int nig = 8 * nN, gid = wgid / nig, fm = gid * 8, gsz = (nM - fm) < 8 ? (nM - fm) : 8;
    pm = fm + ((wgid % nig) % gsz); pn = (wgid % nig) / gsz;
}
struct RetProjSched {
    const char *X, *W; int G, c;
    __device__ __forceinline__ bool next(int i, Unit& u) const {
        const int L = i * G + c; if (L >= 768) return false;
        int pm, pn;
        if (L < 512) { order2d_L(L, 32, 16, pm, pn); u.z = 0; u.a0 = X + (size_t)pm * 256 * 1024 * 2; u.b0 = W + (size_t)pn * 256 * 1024 * 2; }
        else { order2d_L(L - 512, 8, 32, pm, pn); u.z = 1; u.a0 = W + (size_t)(4096 + pm * 256) * 1024 * 2; u.b0 = X + (size_t)pn * 256 * 1024 * 2; }
        u.pm = pm; u.pn = pn; u.a1 = u.a0 + (size_t)128 * 1024 * 2; u.b1 = u.b0 + (size_t)128 * 1024 * 2; return true; }
};
struct GateSched {
    const char *XB, *WGA, *WGX; int G, c;
    __device__ __forceinline__ bool next(int i, Unit& u) const {
        int pm, pn; if (!order2d(i, G, c, 128, 16, pm, pn)) return false;
        const int z = pn >> 2, d = (pn >> 1) & 1, hf = pn & 1; u.pm = pm; u.pn = pn; u.z = 0;
        u.a0 = XB + ((size_t)pm * 256 * 1024 + z * 256) * 2; u.a1 = u.a0 + (size_t)128 * 1024 * 2;
        const size_t bo = (size_t)(((d * 4 + z) * 256 + hf * 128) * 256) * 2; u.b0 = WGA + bo; u.b1 = WGX + bo; return true; }
};
struct FfnUpSched {
    const char *A, *WG, *WU; int G, c;
    __device__ __forceinline__ bool next(int i, Unit& u) const {
        int pm, pn; if (!order2d(i, G, c, 128, 22, pm, pn)) return false;
        u.pm = pm; u.pn = pn; u.z = 0; u.a0 = A + (size_t)pm * 256 * 1024 * 2; u.a1 = u.a0 + (size_t)128 * 1024 * 2;
        u.b0 = WG + (size_t)pn * 128 * 1024 * 2; u.b1 = WU + (size_t)pn * 128 * 1024 * 2; return true; }
};
struct ScoreSched {
    const char *A2, *KB; int G, c;
    __device__ __forceinline__ bool next(int i, Unit& u) const {
        const int L = i * G + c; if (L >= 128) return false;
        const int z = L, bl = z >> 6, h = (z >> 4) & 3, cc = z & 15; u.pm = 0; u.pn = 0; u.z = z;
        u.a0 = A2 + ((size_t)z * 256 * 768 + 256) * 2; u.a1 = u.a0 + (size_t)128 * 768 * 2;
        u.b0 = KB + (((size_t)bl * 4096 + cc * 256) * 1024 + h * 256) * 2; u.b1 = u.b0 + (size_t)128 * 1024 * 2; return true; }
};
struct KvSched {
    const char *BT2, *KTF, *KTB; int G, c;
    __device__ __forceinline__ bool next(int i, Unit& u) const {
        const int L = i * G + c; if (L >= 512) return false;
        const int xq = L & 7, sq_ = L >> 3;
        const int z = xq * 16 + (sq_ >> 2), dir = (sq_ >> 1) & 1, dvh = sq_ & 1, bl = z >> 6, h = (z >> 4) & 3, cc = z & 15; u.pm = dvh; u.pn = dir; u.z = z;
        u.a0 = BT2 + ((size_t)(z * 512 + dvh * 256) * 768) * 2; u.a1 = u.a0 + (size_t)128 * 768 * 2;
        u.b0 = (dir ? KTB : KTF) + ((size_t)(h * 256) * TG + bl * 4096 + cc * 256) * 2; u.b1 = u.b0 + (size_t)128 * TG * 2; return true; }
};
struct YSched {
    const char *A2, *BT2; int G, c;
    __device__ __forceinline__ bool next(int i, Unit& u) const {
        const int L = i * G + c; if (L >= 256) return false;
        const int xq = L & 7, sq_ = L >> 3; const int z = xq * 16 + (sq_ >> 1), dvh = sq_ & 1; u.pm = 0; u.pn = dvh; u.z = z;
        u.a0 = A2 + (size_t)z * 256 * 768 * 2; u.a1 = u.a0 + (size_t)128 * 768 * 2;
        u.b0 = BT2 + ((size_t)(z * 512 + dvh * 256) * 768) * 2; u.b1 = u.b0 + (size_t)128 * 768 * 2; return true; }
};

__device__ __forceinline__ void rows_rs8(const float* ssp, int row0, int fq, float (&rsv)[8]) {
    f32x4 p[8];
#pragma unroll
    for (int i = 0; i < 8; ++i) p[i] = *(const f32x4*)(ssp + (size_t)(row0 + (i >> 2) * 128 + (i & 3) * 16) * 16 + fq * 4);
#pragma unroll
    for (int i = 0; i < 8; ++i) { float s_ = (p[i][0] + p[i][1]) + (p[i][2] + p[i][3]); s_ += __shfl_xor(s_, 16); s_ += __shfl_xor(s_, 32); rsv[i] = rsq(s_ * (1.0f / 1024.0f) + EPS); }
}
__device__ __forceinline__ void rows_rs4(const float* ssp, int row0, int fq, float (&rsv)[4]) {
    f32x4 p[4];
#pragma unroll
    for (int i = 0; i < 4; ++i) p[i] = *(const f32x4*)(ssp + (size_t)(row0 + i * 16) * 16 + fq * 4);
#pragma unroll
    for (int i = 0; i < 4; ++i) { float s_ = (p[i][0] + p[i][1]) + (p[i][2] + p[i][3]); s_ += __shfl_xor(s_, 16); s_ += __shfl_xor(s_, 32); rsv[i] = rsq(s_ * (1.0f / 1024.0f) + EPS); }
}
#ifndef ST_SC1
#define ST_SC1 0
#endif
#if ST_SC1
#define ST16(p, v) do { const u32x4 v_ = (v); const void* p_ = (const void*)(p); asm volatile("global_store_dwordx4 %0, %1, off sc1" :: "v"(p_), "v"(v_) : "memory"); } while (0)
#else
#define ST16(p, v) do { *(u32x4*)(p) = (v); } while (0)
#endif
#define EPI_ARGS AccRef acc, const Unit& u, int wr, int wc, int fr, int fq
__device__ __forceinline__ bool epi_fence() { asm volatile("" ::: "memory"); __builtin_amdgcn_sched_barrier(0); return true; }
#define FOR_AI_M _Pragma("unroll") for (int ai = 0; ai < 2; ++ai) _Pragma("unroll") for (int m = 0; m < 4; ++m) if (epi_fence())

struct EpiP1 {
    bf16_t* xbp; bf16_t* gg;
    __device__ __forceinline__ void operator()(EPI_ARGS) const {
        const int row0 = u.pm * 256 + wr * 64 + fr;
        if (u.pn < 4) {
            FOR_AI_M { bf16_t* rp = xbp + (size_t)(row0 + ai * 128 + m * 16) * 1024 + u.pn * 256 + wc * 32 + fq * 8;
#pragma unroll
                for (int bj = 0; bj < 2; ++bj) ST16((rp + bj * 128), pack8(acc[ai][bj][m][0], acc[ai][bj][m][1])); }
        } else {
            const int b = u.pm >> 4;
            FOR_AI_M { const int t = (row0 + ai * 128 + m * 16) & 4095;
#pragma unroll
                for (int bj = 0; bj < 2; ++bj) { const int cgp = (u.pn - 4) * 8 + bj * 4 + wc;
                    bf16_t* p = gg + ((size_t)((b * 32 + cgp) * 4096 + t)) * 32 + fq * 8;
                    ST16(p, pack8(geluv(acc[ai][bj][m][0]), geluv(acc[ai][bj][m][1]))); } }
        }
    }
};
struct EpiGate {
    const bf16_t* xb; const float *ga_b, *gx_b, *cla; unsigned short* laf; bf16_t* inf; unsigned short* lab; bf16_t* inb;
    __device__ __forceinline__ void operator()(EPI_ARGS) const {
        const int z = u.pn >> 2, d = (u.pn >> 1) & 1, hf = u.pn & 1;
        const int ch0 = z * 256 + hf * 128 + wc * 32 + fq * 8;
        const f32x4 ba0 = *(const f32x4*)(ga_b + d * 1024 + ch0), ba1 = *(const f32x4*)(ga_b + d * 1024 + ch0 + 4);
        const f32x4 bx0 = *(const f32x4*)(gx_b + d * 1024 + ch0), bx1 = *(const f32x4*)(gx_b + d * 1024 + ch0 + 4);
        const f32x4 cl0 = *(const f32x4*)(cla + d * 1024 + ch0), cl1 = *(const f32x4*)(cla + d * 1024 + ch0 + 4);
        const int b = u.pm >> 4, cgp = z * 8 + hf * 4 + wc;
        unsigned short* lap = d ? lab : laf; bf16_t* inp = d ? inb : inf;
        u32x4 xw8[8];
#pragma unroll
        for (int i = 0; i < 8; ++i) xw8[i] = *(const u32x4*)(xb + (size_t)(u.pm * 256 + (i >> 2) * 128 + wr * 64 + (i & 3) * 16 + fr) * 1024 + ch0);
        FOR_AI_M { const int row = u.pm * 256 + ai * 128 + wr * 64 + m * 16 + fr, t = row & 4095;
            const u32x4 xw = xw8[ai * 4 + m];
            const f32x4 x0 = unlo(xw), x1 = unhi(xw);
            const f32x4 r0 = sigv(acc[ai][0][m][0] + ba0), r1 = sigv(acc[ai][0][m][1] + ba1);
            const f32x4 i0 = sigv(acc[ai][1][m][0] + bx0), i1 = sigv(acc[ai][1][m][1] + bx1);
            const f32x4 l0 = r0 * cl0, l1 = r1 * cl1;
            const f32x4 q0 = i0 * x0, q1 = i1 * x1;
            const size_t off = ((size_t)((b * 32 + cgp) * 4096 + t)) * 32 + fq * 8;
            ST16((lap + off), pack8h(l0, l1));
            ST16((inp + off), pack8(q0, q1)); }
    }
};
template <bool BASE_F32, bool SCALED = false> struct EpiRes {
    const float* basef; bf16_t* xn; float* ss; const float* rq;
    __device__ __forceinline__ void operator()(EPI_ARGS) const {
        constexpr bool PIPE = BASE_F32 || SCALED;
        u32x4 bw16[16]; f32x4 fb[2][4]; u32x4 bb[2][2]; float scb[2] = {1.f, 1.f};
        const size_t off00 = (size_t)(u.pm * 256 + wr * 64 + fr) * 1024 + u.pn * 256 + wc * 32 + fq * 8;
        if constexpr (!PIPE) {
#pragma unroll
            for (int i = 0; i < 16; ++i) bw16[i] = *(const u32x4*)(xn + off00 + (size_t)((i >> 3) * 128 + ((i >> 1) & 3) * 16) * 1024 + (i & 1) * 128);
        } else if constexpr (BASE_F32) {
#pragma unroll
            for (int q = 0; q < 4; ++q) fb[0][q] = *(const f32x4*)(basef + off00 + (q >> 1) * 128 + (q & 1) * 4);
        } else {
            bb[0][0] = *(const u32x4*)(xn + off00); bb[0][1] = *(const u32x4*)(xn + off00 + 128); scb[0] = rq[(size_t)(u.pm * 256 + wr * 64 + fr) * 4 + 3];
        }
        FOR_AI_M { const int row = u.pm * 256 + ai * 128 + wr * 64 + m * 16 + fr; float sq = 0.f; const int k = ai * 4 + m;
            if constexpr (PIPE) { if (k < 7) { const int k1 = k + 1; const size_t o1 = off00 + (size_t)((k1 >> 2) * 128 + (k1 & 3) * 16) * 1024;
                if constexpr (BASE_F32) {
#pragma unroll
                    for (int q = 0; q < 4; ++q) fb[k1 & 1][q] = *(const f32x4*)(basef + o1 + (q >> 1) * 128 + (q & 1) * 4);
                } else { bb[k1 & 1][0] = *(const u32x4*)(xn + o1); bb[k1 & 1][1] = *(const u32x4*)(xn + o1 + 128);
                    scb[k1 & 1] = rq[(size_t)(u.pm * 256 + (k1 >> 2) * 128 + wr * 64 + (k1 & 3) * 16 + fr) * 4 + 3]; } } }
            const float sc = SCALED ? scb[k & 1] : 1.0f;
#pragma unroll
            for (int bj = 0; bj < 2; ++bj) { const size_t off = (size_t)row * 1024 + u.pn * 256 + bj * 128 + wc * 32 + fq * 8;
                f32x4 h0, h1;
                if constexpr (BASE_F32) { h0 = fb[k & 1][bj * 2] + acc[ai][bj][m][0]; h1 = fb[k & 1][bj * 2 + 1] + acc[ai][bj][m][1]; }
                else { const u32x4 bw = SCALED ? bb[k & 1][bj] : bw16[k * 2 + bj]; h0 = unlo(bw) + acc[ai][bj][m][0] * sc; h1 = unhi(bw) + acc[ai][bj][m][1] * sc; }
                ST16((xn + off), pack8(h0, h1));
                sq += (h0[0] * h0[0] + h0[1] * h0[1]) + (h0[2] * h0[2] + h0[3] * h0[3]) + (h1[0] * h1[0] + h1[1] * h1[1]) + (h1[2] * h1[2] + h1[3] * h1[3]); }
            sq += __shfl_xor(sq, 16); sq += __shfl_xor(sq, 32);
            if (fq == 0) ss[(size_t)row * 16 + u.pn * 4 + wc] = sq; }
    }
};
struct EpiFfnUp {
    const float* ss; bf16_t* act;
    __device__ __forceinline__ void operator()(EPI_ARGS) const {
        float rsv[8]; rows_rs8(ss, u.pm * 256 + wr * 64 + fr, fq, rsv);
        FOR_AI_M { const int row = u.pm * 256 + ai * 128 + wr * 64 + m * 16 + fr; const float rs = rsv[ai * 4 + m];
            const f32x4 g0 = acc[ai][0][m][0] * rs, g1 = acc[ai][0][m][1] * rs, u0 = acc[ai][1][m][0] * rs, u1 = acc[ai][1][m][1] * rs;
            ST16((act + (size_t)row * FF + u.pn * 128 + wc * 32 + fq * 8), pack8(g0 * sigv(g0) * u0, g1 * sigv(g1) * u1)); }
    }
};
struct EpiRetA {
    const float* ss; const float *cost, *sint; bf16_t *a2, *sg, *kb; int g;
    __device__ __forceinline__ void operator()(EPI_ARGS) const {
        const int bl = u.pm >> 4, cc = u.pm & 15;
        if (u.pn >= 4 && u.pn < 12) {
#pragma unroll
            for (int ai = 0; ai < 2; ++ai) { float rs4[4]; rows_rs4(ss, g * TG + u.pm * 256 + ai * 128 + wr * 64 + fr, fq, rs4);
#pragma unroll
                for (int m = 0; m < 4; ++m) if (epi_fence()) { const int r = ai * 128 + wr * 64 + m * 16 + fr, rowg = u.pm * 256 + r; const float rs = rs4[m];
#pragma unroll
                    for (int bj = 0; bj < 2; ++bj) { const f32x4 v0 = acc[ai][bj][m][0] * rs, v1 = acc[ai][bj][m][1] * rs;
                        ST16((sg + (size_t)rowg * 2048 + (u.pn - 4) * 256 + bj * 128 + wc * 32 + fq * 8), pack8(v0 * sigv(v0), v1 * sigv(v1))); } } }
        } else {
            const bool isq = u.pn < 4; const int h = isq ? u.pn : u.pn - 12; const int j0 = wc * 32 + fq * 8;
            const float lf = l2gam(h), lb = l2gam(3 - h);
#pragma unroll
            for (int ai = 0; ai < 2; ++ai) { float rs4[4]; rows_rs4(ss, g * TG + u.pm * 256 + ai * 128 + wr * 64 + fr, fq, rs4);
                f32x4 tb[2][4];
                { const int pos = (u.pm * 256 + ai * 128 + wr * 64 + fr) & 4095; tb[0][0] = *(const f32x4*)(cost + pos * 128 + j0); tb[0][1] = *(const f32x4*)(cost + pos * 128 + j0 + 4);
                  tb[0][2] = *(const f32x4*)(sint + pos * 128 + j0); tb[0][3] = *(const f32x4*)(sint + pos * 128 + j0 + 4); }
#pragma unroll
                for (int m = 0; m < 4; ++m) if (epi_fence()) { const int r = ai * 128 + wr * 64 + m * 16 + fr, rowg = u.pm * 256 + r; const float rs = rs4[m];
                    if (m < 3) { const int pn_ = (rowg + 16) & 4095; tb[(m + 1) & 1][0] = *(const f32x4*)(cost + pn_ * 128 + j0); tb[(m + 1) & 1][1] = *(const f32x4*)(cost + pn_ * 128 + j0 + 4);
                        tb[(m + 1) & 1][2] = *(const f32x4*)(sint + pn_ * 128 + j0); tb[(m + 1) & 1][3] = *(const f32x4*)(sint + pn_ * 128 + j0 + 4); }
                    const f32x4 c0 = tb[m & 1][0], c1 = tb[m & 1][1], s0 = tb[m & 1][2], s1 = tb[m & 1][3];
                    const f32x4 x10 = acc[ai][0][m][0] * rs, x11 = acc[ai][0][m][1] * rs, x20 = acc[ai][1][m][0] * rs, x21 = acc[ai][1][m][1] * rs;
                    const f32x4 o10 = x10 * c0 - x20 * s0, o11 = x11 * c1 - x21 * s1, o20 = x20 * c0 + x10 * s0, o21 = x21 * c1 + x11 * s1;
                    if (isq) {
                        const float wf = ex2(lf * (float)(r + 1)), wb = ex2(lb * (float)(256 - r));
                        bf16_t* p = a2 + ((size_t)(((bl * 4 + h) * 16 + cc) * 256 + r)) * 768 + 256 + j0;
                        ST16((p), pack8(o10 * wf, o11 * wf)); ST16((p + 128), pack8(o20 * wf, o21 * wf));
                        ST16((p + 256), pack8(o10 * wb, o11 * wb)); ST16((p + 384), pack8(o20 * wb, o21 * wb));
                    } else {
                        bf16_t* p = kb + (size_t)rowg * 1024 + h * 256 + j0;
                        ST16((p), pack8(o10 * 0.0625f, o11 * 0.0625f)); ST16((p + 128), pack8(o20 * 0.0625f, o21 * 0.0625f));
                    } } }
        }
    }
};
struct EpiRetB {
    const float* ss; bf16_t* bt2; int g;
    __device__ __forceinline__ void operator()(EPI_ARGS) const {
        const int bl = u.pn >> 4, cc = u.pn & 15;
#pragma unroll
        for (int bj = 0; bj < 2; ++bj) {
            const int jt0 = bj * 128 + wc * 32 + fq * 8, tl0 = u.pn * 256 + jt0;
            f32x4 rs0, rs1;
#pragma unroll
            for (int e = 0; e < 4; ++e) { rs0[e] = row_rs(ss, g * TG + tl0 + e); rs1[e] = row_rs(ss, g * TG + tl0 + 4 + e); }
            FOR_AI_M { const int vrow = u.pm * 256 + ai * 128 + wr * 64 + m * 16 + fr, h = vrow >> 9, dv = vrow & 511;
                ST16((bt2 + ((size_t)(((bl * 4 + h) * 16 + cc) * 512 + dv)) * 768 + jt0), pack8(acc[ai][bj][m][0] * rs0, acc[ai][bj][m][1] * rs1)); }
        }
    }
};
struct EpiRetAB { EpiRetA a; EpiRetB b;
    __device__ __forceinline__ void operator()(EPI_ARGS) const { if (u.z == 0) a(acc, u, wr, wc, fr, fq); else b(acc, u, wr, wc, fr, fq); }
};
struct EpiScore {
    bf16_t* a2;
    __device__ __forceinline__ void operator()(EPI_ARGS) const {
        const int h = (u.z >> 4) & 3; const float lf = l2gam(h), lb = l2gam(3 - h);
        FOR_AI_M { const int jn = ai * 128 + wr * 64 + m * 16 + fr;
#pragma unroll
            for (int bj = 0; bj < 2; ++bj) { const int jm0 = bj * 128 + wc * 32 + fq * 8; f32x4 p0, p1;
#pragma unroll
                for (int e = 0; e < 4; ++e) { const int ja = jm0 + e, jb = jm0 + 4 + e;
                    const float ea = -lf * (float)(min(ja, jn) + 1) + lb * (float)max(ja - jn, 0);
                    const float eb = -lf * (float)(min(jb, jn) + 1) + lb * (float)max(jb - jn, 0);
                    p0[e] = acc[ai][bj][m][0][e] * ex2(ea); p1[e] = acc[ai][bj][m][1][e] * ex2(eb); }
                ST16((a2 + ((size_t)(u.z * 256 + jn)) * 768 + jm0), pack8(p0, p1)); } }
    }
};
struct EpiKv {
    bf16_t* bt2;
    __device__ __forceinline__ void operator()(EPI_ARGS) const {
        FOR_AI_M { const int r = ai * 128 + wr * 64 + m * 16 + fr;
            bf16_t* p = bt2 + ((size_t)(u.z * 512 + u.pm * 256 + r)) * 768 + 256 + u.pn * 256 + wc * 32 + fq * 8;
#pragma unroll
            for (int bj = 0; bj < 2; ++bj) ST16((p + bj * 128), pack8(acc[ai][bj][m][0], acc[ai][bj][m][1])); }
    }
};
struct EpiY {
    bf16_t* yz; float* yss; const bf16_t* sg; int g;
    __device__ __forceinline__ void operator()(EPI_ARGS) const {
        const int bl = u.z >> 6, h = (u.z >> 4) & 3, cc = u.z & 15;
#pragma unroll
        for (int ai = 0; ai < 2; ++ai) { u32x4 gw8[8];
#pragma unroll
          for (int i = 0; i < 8; ++i) gw8[i] = *(const u32x4*)(sg + (size_t)(bl * 4096 + cc * 256 + ai * 128 + wr * 64 + (i >> 1) * 16 + fr) * 2048 + h * 512 + u.pn * 256 + wc * 32 + fq * 8 + (i & 1) * 128);
#pragma unroll
          for (int m = 0; m < 4; ++m) if (epi_fence()) { const int r = ai * 128 + wr * 64 + m * 16 + fr, tok = g * TG + bl * 4096 + cc * 256 + r; float sq = 0.f;
            bf16_t* p = yz + (size_t)tok * 2048 + h * 512 + u.pn * 256 + wc * 32 + fq * 8;
#pragma unroll
            for (int bj = 0; bj < 2; ++bj) { const f32x4 v0 = acc[ai][bj][m][0], v1 = acc[ai][bj][m][1];
                const u32x4 gw_ = gw8[m * 2 + bj];
                ST16((p + bj * 128), pack8(v0 * unlo(gw_), v1 * unhi(gw_)));
                sq += (v0[0] * v0[0] + v0[1] * v0[1]) + (v0[2] * v0[2] + v0[3] * v0[3]) + (v1[0] * v1[0] + v1[1] * v1[1]) + (v1[2] * v1[2] + v1[3] * v1[3]); }
            sq += __shfl_xor(sq, 16); sq += __shfl_xor(sq, 32);
            if (fq == 0) yss[(size_t)(tok * 4 + h) * 8 + u.pn * 4 + wc] = sq; } }
    }
};

__device__ __forceinline__ float wave_sum(float v) {
#pragma unroll
    for (int o = 1; o < 64; o <<= 1) v += __shfl_xor(v, o);
    return v;
}
__device__ __forceinline__ void tr_load(const float* W, int ldw, int nblk, int item, int lane, f32x4 (&v)[8]) {
    const int kb = item / nblk, nb = item % nblk, k0 = 64 * kb, n0 = 32 * nb, n4 = (lane & 7) * 4;
#pragma unroll
    for (int i = 0; i < 8; ++i) v[i] = *(const f32x4*)(W + (size_t)(k0 + i * 8 + (lane >> 3)) * ldw + n0 + n4);
}
__device__ __forceinline__ void tr_finish(const f32x4 (&v)[8], int K, int nblk, bf16_t* WT, LAS float* scr, int item, int lane, const float* gain) {
    const int kb = item / nblk, nb = item % nblk, k0 = 64 * kb, n0 = 32 * nb, n4 = (lane & 7) * 4;
#pragma unroll
    for (int i = 0; i < 8; ++i) { const int kk = i * 8 + (lane >> 3); const float gv = gain ? gain[k0 + kk] : 1.0f;
#pragma unroll
        for (int e = 0; e < 4; ++e) scr[kk * 33 + n4 + e] = v[i][e] * gv; }
    asm volatile("s_waitcnt lgkmcnt(0)" ::: "memory");
    const int c = lane & 7;
#pragma unroll
    for (int j = 0; j < 4; ++j) { const int n = (lane >> 3) + 8 * j; const LAS float* s = scr + (8 * c) * 33 + n;
        u32x4 o; o.x = cvt_pk_bf16(s[0 * 33], s[1 * 33]); o.y = cvt_pk_bf16(s[2 * 33], s[3 * 33]); o.z = cvt_pk_bf16(s[4 * 33], s[5 * 33]); o.w = cvt_pk_bf16(s[6 * 33], s[7 * 33]);
        ST16((WT + (size_t)(n0 + n) * K + k0 + 8 * c), o); }
    asm volatile("s_waitcnt lgkmcnt(0)" ::: "memory");
}
__device__ __forceinline__ void tr_item(const float* W, int ldw, int K, int nblk, bf16_t* WT, LAS float* scr, int item, int lane, const float* gain) {
    f32x4 v[8]; tr_load(W, ldw, nblk, item, lane, v); tr_finish(v, K, nblk, WT, scr, item, lane, gain);
}
__device__ __forceinline__ void tr_job(const float* W, int ldw, int K, int N, bf16_t* WT, const float* gain, LAS float* scr, int gw, int NGW, int lane) {
    const int nblk = N / 32, nitems = (K / 64) * nblk;
    for (int it = gw; it < nitems; it += NGW) tr_item(W, ldw, K, nblk, WT, scr, it, lane, gain);
}


#define SS1 ((float*)(ws + WS_SS1))
#define SS2 ((float*)(ws + WS_SS2))
#define SS3 ((float*)(ws + WS_SS3))
#define SS4 ((float*)(ws + WS_SS4))
#define YSS ((float*)(ws + WS_YSS))
#define COST ((float*)(ws + WS_COST))
#define SINT ((float*)(ws + WS_SINT))
#define COSJ ((float*)(ws + WS_COSJ))
#define SINJ ((float*)(ws + WS_SINJ))
#define CLA ((float*)(ws + WS_CLA))
#define WIN ((bf16_t*)(ws + WS_WIN))
#define WGA ((bf16_t*)(ws + WS_WGA))
#define WGX ((bf16_t*)(ws + WS_WGX))
#define WLO ((bf16_t*)(ws + WS_WLO))
#define WFG ((bf16_t*)(ws + WS_WFG))
#define WFU ((bf16_t*)(ws + WS_WFU))
#define WFD ((bf16_t*)(ws + WS_WFD))
#define WRI ((bf16_t*)(ws + WS_WRI))
#define WRO ((bf16_t*)(ws + WS_WRO))
#define XN ((bf16_t*)(ws + WS_XN))
#define XBP ((bf16_t*)(ws + WS_XBP))
#define GG ((bf16_t*)(ws + WS_GG))
#define XB ((bf16_t*)(ws + WS_XB))
#define YL ((bf16_t*)(ws + WS_YL))
#define ACT ((bf16_t*)(ws + WS_ACT))
#define YZ ((bf16_t*)(ws + WS_YZ))
#define A2 ((bf16_t*)(ws + WS_A2))
#define KB ((bf16_t*)(ws + WS_KB))
#define KTF ((bf16_t*)(ws + WS_KTF))
#define KTB ((bf16_t*)(ws + WS_KTB))
#define BT2 ((bf16_t*)(ws + WS_BT2))
#define SG ((bf16_t*)(ws + WS_SG))
#define INF ((bf16_t*)(ws + WS_INF))
#define INB ((bf16_t*)(ws + WS_INB))
#define LAF ((unsigned short*)(ws + WS_LAF))
#define LAB ((unsigned short*)(ws + WS_LAB))

#ifndef PHMASK
#define PHMASK 0xFFFFFFFFu
#endif
#define PHX(k) ((PHMASK >> (k)) & 1u)
#ifndef REPMASK
#define REPMASK 0u
#endif
#define NREP(k) (1 + (int)((REPMASK >> (k)) & 1u))
#ifndef SUBMASK
#define SUBMASK 3u
#endif

#ifdef DBG
constexpr size_t WS_DBG = 9 * MiB + 65536, WS_DBGBUF = 9 * MiB + 131072;
__device__ __forceinline__ float bfv(const bf16_t* p, size_t i) { return __uint_as_float((unsigned)p[i] << 16); }
__device__ __forceinline__ float hfv(const unsigned short* p, size_t i) { unsigned short v = p[i]; _Float16 h = __builtin_bit_cast(_Float16, v); return (float)h; }
__device__ __forceinline__ bool close_(float got, float ref, float rtol, float atol) { return fabsf(got - ref) <= atol + rtol * fabsf(ref); }
__device__ __forceinline__ unsigned hsh(unsigned x) { x ^= x >> 16; x *= 0x7feb352dU; x ^= x >> 15; x *= 0x846ca68bU; x ^= x >> 16; return x; }
__device__ __forceinline__ float bfr(float x) { unsigned u = __float_as_uint(x); u += 0x7fffu + ((u >> 16) & 1u); return __uint_as_float(u & 0xffff0000u); }
#define DFAIL(code) do { if (__hip_atomic_load(dbg, __ATOMIC_RELAXED, __HIP_MEMORY_SCOPE_AGENT) == 0u) atomicCAS(dbg, 0u, (unsigned)(code)); } while (0)
#define DCHK(code, got, ref, rtol, atol) do { if (!close_((got), (ref), (rtol), (atol))) DFAIL(code); } while (0)
#endif

#define XB_TMO      128
#define XB_XCNT(j)  (256  + 64 * (j))
#define XB_XSUB(j)  (1280 + 64 * (j))
#define XB_XGEN(j)  (2304 + 64 * (j))
#define XB_TOP      3328
#define XB_TOPGEN   3392
#define XCD_BAR_WORDS 3456
#define XB_SPIN_CAP (1u << 22)
constexpr size_t WS_BAR = 9 * MiB + 16384;
constexpr int MISC_OFF = 131072 + 320;
__device__ __forceinline__ unsigned xb_ld(unsigned* p)              { return __hip_atomic_load(p, __ATOMIC_RELAXED, __HIP_MEMORY_SCOPE_AGENT); }
__device__ __forceinline__ unsigned xb_add(unsigned* p, unsigned v) { return __hip_atomic_fetch_add(p, v, __ATOMIC_RELAXED, __HIP_MEMORY_SCOPE_AGENT); }
__device__ __forceinline__ unsigned xb_xcc_id() { return (unsigned)__builtin_amdgcn_s_getreg((3 << 11) | 20) & 0xFu; }
#define XB_SPIN(cond, bar) do { unsigned _sp = 0; while (cond) { __builtin_amdgcn_s_sleep(1); \
    if ((++_sp & 255u) == 0u) { if (xb_ld(&(bar)[XB_TMO])) break; if (_sp > XB_SPIN_CAP) { atomicAdd(&(bar)[XB_TMO], 1u); break; } } } } while (0)
struct XcdBarrier { unsigned* bar; unsigned x; volatile LAS unsigned* st; };
__device__ __forceinline__ XcdBarrier xcd_barrier_post(unsigned* bar, volatile LAS unsigned* st) {
    XcdBarrier b; b.bar = bar; b.x = xb_xcc_id(); b.st = st;
    if (threadIdx.x == 0) (void)xb_add(&bar[XB_XCNT(b.x)], 1u);
    return b;
}
__device__ __forceinline__ void xcd_barrier_complete(unsigned* bar, unsigned x, unsigned& nloc, unsigned& nx) {
    const unsigned G = gridDim.x * gridDim.y * gridDim.z;
    unsigned sum, cnt, mine, sp = 0u;
    for (;;) {
        sum = 0u; cnt = 0u; mine = 0u;
#pragma unroll
        for (unsigned j = 0; j < 16; ++j) { const unsigned c = xb_ld(&bar[XB_XCNT(j)]); sum += c; cnt += (c > 0u) ? 1u : 0u; mine = (j == x) ? c : mine; }
        if (sum == G) break;
        __builtin_amdgcn_s_sleep(1);
        if ((++sp & 255u) == 0u) { if (xb_ld(&bar[XB_TMO])) break; if (sp > XB_SPIN_CAP) { atomicAdd(&bar[XB_TMO], 1u); break; } }
    }
    nloc = mine > 0u ? mine : 1u; nx = cnt > 0u ? cnt : 1u;
}
__device__ __forceinline__ void xcd_barrier(const XcdBarrier& b) {
    asm volatile("s_waitcnt vmcnt(0)" ::: "memory");
    __syncthreads();
    if (threadIdx.x == 0) {
        unsigned* bar = b.bar; unsigned bx = xb_xcc_id(); asm volatile("" : "+s"(bar), "+s"(bx));
        __builtin_amdgcn_s_waitcnt(0);
        unsigned nloc = b.st[0], nx = b.st[1];
        if (nloc == 0u) { xcd_barrier_complete(bar, bx, nloc, nx); b.st[0] = nloc; b.st[1] = nx; }
        const unsigned old = xb_add(&bar[XB_XSUB(bx)], 1u);
        const unsigned gen = old / nloc;
        if (old + 1u == (gen + 1u) * nloc) {
            __builtin_amdgcn_fence(__ATOMIC_RELEASE, "agent");
            asm volatile("s_waitcnt vmcnt(0)" ::: "memory");
            const unsigned og = xb_add(&bar[XB_TOP], 1u);
            const unsigned tg = og / nx;
            if (og + 1u == (tg + 1u) * nx) xb_add(&bar[XB_TOPGEN], 1u);
            else XB_SPIN(xb_ld(&bar[XB_TOPGEN]) == tg, bar);
            __builtin_amdgcn_fence(__ATOMIC_ACQUIRE, "agent");
            xb_add(&bar[XB_XGEN(bx)], 1u);
            asm volatile("s_waitcnt vmcnt(0)" ::: "memory");
        } else {
            XB_SPIN(xb_ld(&bar[XB_XGEN(bx)]) == gen, bar);
            __builtin_amdgcn_fence(__ATOMIC_ACQUIRE, "agent");
            asm volatile("s_waitcnt vmcnt(0)" ::: "memory");
        }
    }
    __syncthreads();
}

struct Args { const float* in[18]; float* out; unsigned char* ws; int ph_lo, ph_hi; };


#ifdef DBG
__device__ __forceinline__ void dbg_check(int p, const Args& args, int tid) {
    unsigned char* ws = args.ws; unsigned* dbg = (unsigned*)(ws + WS_DBG); float* dbuf = (float*)(ws + WS_DBGBUF);
    const float* x = args.in[0]; const float* ln_mix = args.in[1]; const float* ln_ffn = args.in[2]; float* out = args.out;
    const unsigned r = hsh(tid * 7u + 1u + 977u * (unsigned)p);
    if (p == 0) {
        { const int n = r % 2048, k = (r >> 11) % 1024; DCHK(10, bfv(WIN, (size_t)n * 1024 + k), args.in[4][(size_t)k * 2048 + n], 0.008f, 1e-6f); }
        { const int mat = r % 8, j = (r >> 3) % 256, k = (r >> 11) % 256; DCHK(11, bfv(WGA, (size_t)mat * 65536 + j * 256 + k), args.in[7][(size_t)mat * 65536 + k * 256 + j], 0.008f, 1e-6f);
          DCHK(11, bfv(WGX, (size_t)mat * 65536 + j * 256 + k), args.in[9][(size_t)mat * 65536 + k * 256 + j], 0.008f, 1e-6f); }
        { const int l = r & 1, n = (r >> 1) % FF, k = (r >> 13) % 1024; const float gv = ln_ffn[l * 1024 + k];
          DCHK(12, bfv(WFG, (size_t)l * FF * 1024 + (size_t)n * 1024 + k), args.in[15][(size_t)l * 1024 * FF + (size_t)k * FF + n] * gv, 0.008f, 1e-6f);
          DCHK(12, bfv(WFU, (size_t)l * FF * 1024 + (size_t)n * 1024 + k), args.in[16][(size_t)l * 1024 * FF + (size_t)k * FF + n] * gv, 0.008f, 1e-6f); }
        { const int l = r & 1, n = (r >> 1) % 1024, k = (r >> 11) % FF; DCHK(13, bfv(WFD, (size_t)l * FF * 1024 + (size_t)n * FF + k), args.in[17][(size_t)l * FF * 1024 + (size_t)k * 1024 + n], 0.008f, 1e-6f); }
        { const int n = r % 6144, k = (r >> 13) % 1024; const int col = n < 1024 ? n : (n < 3072 ? 4096 + (n - 1024) : (n < 4096 ? 1024 + (n - 3072) : 2048 + (n - 4096)));
          DCHK(14, bfv(WRI, (size_t)n * 1024 + k), args.in[13][(size_t)k * 6144 + col] * ln_mix[1024 + k], 0.008f, 1e-6f); }
        { const int row = r % T, col = (r >> 15) % 1024; float ss = 0.f; for (int k = 0; k < 1024; ++k) { const float v = x[(size_t)row * 1024 + k]; ss += v * v; }
          DCHK(15, bfv(XN, (size_t)row * 1024 + col), x[(size_t)row * 1024 + col] * (1.0f / sqrtf(ss / 1024.0f + EPS)) * ln_mix[col], 0.01f, 1e-5f); }
        { const int pos = r % 4096, j = (r >> 12) % 128; const double ang = (double)pos * exp(-((double)j / 127.0) * 9.210340371976184);
          DCHK(16, COST[pos * 128 + j], (float)cos(ang), 0.f, 2e-3f); DCHK(16, SINT[pos * 128 + j], (float)sin(ang), 0.f, 2e-3f);
          DCHK(16, COSJ[j * 4096 + pos], (float)cos(ang), 0.f, 2e-3f); DCHK(16, SINJ[j * 4096 + pos], (float)sin(ang), 0.f, 2e-3f); }
        { const int n = r % 1024, k = (r >> 10) % 1024; DCHK(17, bfv(WLO, (size_t)n * 1024 + k), args.in[12][(size_t)k * 1024 + n], 0.008f, 1e-6f);
          const int k2 = (r >> 10) % 2048; DCHK(17, bfv(WRO, (size_t)n * 2048 + k2), args.in[14][(size_t)k2 * 1024 + n], 0.008f, 1e-6f); }
    } else if (p == 1) {
        const int row = r % T, col = (r >> 15) % 2048; float ref = 0.f;
        for (int k = 0; k < 1024; ++k) ref += bfv(XN, (size_t)row * 1024 + k) * bfv(WIN, (size_t)col * 1024 + k);
        if (col < 1024) DCHK(20, bfv(XBP, (size_t)row * 1024 + col), ref, 0.01f, 2e-3f);
        else { const int ch = col - 1024, b = row >> 12, t = row & 4095; const float u = 0.7978845608f * (ref + 0.044715f * ref * ref * ref);
            DCHK(21, bfv(GG, ((size_t)((b * 32 + ch / 32) * 4096 + t)) * 32 + ch % 32), 0.5f * ref * (1.0f + tanhf(u)), 0.02f, 3e-3f); }
    } else if (p == 2) {
        const int row = r % T, ch = (r >> 15) % 1024, pos = row & 4095; float ref = args.in[6][ch];
        for (int j = 0; j < 4; ++j) { const int pp = pos + j - 2; if (pp >= 0 && pp < 4096) ref += args.in[5][j * 1024 + ch] * bfv(XBP, (size_t)(row + j - 2) * 1024 + ch); }
        DCHK(30, bfv(XB, (size_t)row * 1024 + ch), ref, 0.01f, 2e-3f);
    } else if (p == 3) {
        const int row = r % T, ch = (r >> 15) % 1024, d = (r >> 25) & 1, z = ch >> 8, j = ch & 255, b = row >> 12, t = row & 4095; float pa = args.in[8][d * 1024 + ch], px = args.in[10][d * 1024 + ch];
        for (int k = 0; k < 256; ++k) { const float xv = bfv(XB, (size_t)row * 1024 + z * 256 + k); pa += xv * bfv(WGA, (size_t)((d * 4 + z) * 256 + j) * 256 + k); px += xv * bfv(WGX, (size_t)((d * 4 + z) * 256 + j) * 256 + k); }
        const float rr = 1.0f / (1.0f + expf(-pa)), ii = 1.0f / (1.0f + expf(-px)); const float la2 = rr * CLA[d * 1024 + ch]; const float a = exp2f(la2);
        const float inp = ii * bfv(XB, (size_t)row * 1024 + ch); (void)a;
        const size_t off = ((size_t)((b * 32 + ch / 32) * 4096 + t)) * 32 + ch % 32;
        DCHK(40 + d, hfv(d ? LAB : LAF, off), la2, 0.02f, 1e-5f); DCHK(42 + d, bfv(d ? INB : INF, off), inp, 0.03f, 2e-3f);
        { const float lam = args.in[11][d * 1024 + ch]; DCHK(44, CLA[d * 1024 + ch], -8.0f * log1pf(expf(-lam)) * 1.4426950408889634f, 1e-3f, 1e-7f); }
    } else if (p == 4) {
        { const float* dc = dbuf + 16384; const int ch = tid & 31, sc = (tid >> 5) * 8 + (r % 8); const size_t sl = ch; float hf = 0.f, hb = 0.f;
          for (int q = 0; q < sc * 32; ++q) hf = ({ const float a_ = exp2f(hfv(LAF, sl + (size_t)q * 32)); a_ * hf + sqrtf(fmaxf(1.0f - a_ * a_, 0.f)) * bfv(INF, sl + (size_t)q * 32); });
          for (int q = 4095; q >= (sc + 1) * 32; --q) hb = ({ const float a_ = exp2f(hfv(LAB, sl + (size_t)q * 32)); a_ * hb + sqrtf(fmaxf(1.0f - a_ * a_, 0.f)) * bfv(INB, sl + (size_t)q * 32); });
          { const float* d2 = dbuf + 32768; float ls = 0.f, hl = 0.f; for (int q = sc * 32; q < sc * 32 + 32; ++q) { const float l = hfv(LAF, sl + (size_t)q * 32); ls += l; { const float a_ = exp2f(l); hl = a_ * hl + sqrtf(fmaxf(1.0f - a_ * a_, 0.f)) * bfv(INF, sl + (size_t)q * 32); } }
            DCHK(57, d2[sc * 32 + ch], ls, 0.01f, 1e-4f); DCHK(58, d2[4096 + sc * 32 + ch], hl, 0.02f, 1e-2f); }
          DCHK(sc == 0 ? 51 : (sc == 1 ? 54 : (sc < 8 ? 55 : 56)), dc[sc * 32 + ch], hf, 0.02f, 1e-2f); DCHK(52, dc[4096 + sc * 32 + ch], hb, 0.02f, 1e-2f);
          const int t = sc * 32 + ((r >> 3) & 31); hf = 0.f; hb = 0.f;
          for (int q = 0; q <= t; ++q) hf = ({ const float a_ = exp2f(hfv(LAF, sl + (size_t)q * 32)); a_ * hf + sqrtf(fmaxf(1.0f - a_ * a_, 0.f)) * bfv(INF, sl + (size_t)q * 32); });
          for (int q = 4095; q >= t; --q) hb = ({ const float a_ = exp2f(hfv(LAB, sl + (size_t)q * 32)); a_ * hb + sqrtf(fmaxf(1.0f - a_ * a_, 0.f)) * bfv(INB, sl + (size_t)q * 32); });
          DCHK(53, bfv(YL, (size_t)t * 1024 + ch), (hf + hb) * bfv(GG, sl + (size_t)t * 32), 0.03f, 3e-2f); }
        const int b = r % 8, ch = (r >> 3) % 1024, t = (r >> 13) % 4096; const size_t slab = ((size_t)(b * 32 + ch / 32) * 4096) * 32 + ch % 32; float hf = 0.f, hb = 0.f;
        for (int q = 0; q <= t; ++q) hf = ({ const float a_ = exp2f(hfv(LAF, slab + (size_t)q * 32)); a_ * hf + sqrtf(fmaxf(1.0f - a_ * a_, 0.f)) * bfv(INF, slab + (size_t)q * 32); });
        for (int q = 4095; q >= t; --q) hb = ({ const float a_ = exp2f(hfv(LAB, slab + (size_t)q * 32)); a_ * hb + sqrtf(fmaxf(1.0f - a_ * a_, 0.f)) * bfv(INB, slab + (size_t)q * 32); });
        DCHK(50, bfv(YL, (size_t)(b * 4096 + t) * 1024 + ch), (hf + hb) * bfv(GG, slab + (size_t)t * 32), 0.03f, 3e-2f);
    } else if (p == 5) {
        const int row = r % T, col = (r >> 15) % 1024; float ref = x[(size_t)row * 1024 + col];
        for (int k = 0; k < 1024; ++k) ref += bfv(YL, (size_t)row * 1024 + k) * bfv(WLO, (size_t)col * 1024 + k);
        DCHK(60, out[(size_t)row * 1024 + col], ref, 0.01f, 5e-3f); DCHK(61, bfv(XN, (size_t)row * 1024 + col), ref, 0.02f, 5e-3f);
        float ss = 0.f; for (int k = 0; k < 1024; ++k) { const float v = out[(size_t)row * 1024 + k]; ss += v * v; }
        DCHK(62, SS1[row], ss, 0.01f, 1e-3f);
    } else if (p == 6) {
        const int row = r % T, j = (r >> 15) % FF; float g = 0.f, u = 0.f;
        for (int k = 0; k < 1024; ++k) { const float xv = bfv(XN, (size_t)row * 1024 + k); g += xv * bfv(WFG, (size_t)j * 1024 + k); u += xv * bfv(WFU, (size_t)j * 1024 + k); }
        const float rs = 1.0f / sqrtf(SS1[row] / 1024.0f + EPS); g *= rs; u *= rs;
        DCHK(70, bfv(ACT, (size_t)row * FF + j), g / (1.0f + expf(-g)) * u, 0.03f, 5e-3f);
        { const unsigned r2 = hsh(tid * 7u + 1u + 977u * 7u); const int row2 = r2 % T, col2 = (r2 >> 15) % 1024; dbuf[tid] = out[(size_t)row2 * 1024 + col2]; }
    } else if (p == 7) {
        const int row = r % T, col = (r >> 15) % 1024; float ref = dbuf[tid];
        for (int k = 0; k < FF; ++k) ref += bfv(ACT, (size_t)row * FF + k) * bfv(WFD, (size_t)col * FF + k);
        DCHK(80, out[(size_t)row * 1024 + col], ref, 0.01f, 5e-3f);
    } else if (p == 8) {
        const int tl = r % TG, h = (r >> 13) % 4, j = (r >> 15) % 128, pos = tl & 4095, jt = tl & 255, bl = tl >> 12, cc = (tl >> 8) & 15, z = (bl * 4 + h) * 16 + cc;
        const float rs = 1.0f / sqrtf(SS2[tl] / 1024.0f + EPS); const float cv = COST[pos * 128 + j], sv = SINT[pos * 128 + j];
        const float lf = l2gam(h), lb = l2gam(3 - h);
        { float x1 = 0.f, x2 = 0.f; for (int k = 0; k < 1024; ++k) { const float xv = bfv(XN, (size_t)tl * 1024 + k); x1 += xv * bfv(WRI, (size_t)(h * 256 + j) * 1024 + k); x2 += xv * bfv(WRI, (size_t)(h * 256 + 128 + j) * 1024 + k); }
          x1 *= rs; x2 *= rs; const float o1 = x1 * cv - x2 * sv, o2 = x2 * cv + x1 * sv; const float wf = exp2f(lf * (float)(jt + 1)), wb = exp2f(lb * (float)(256 - jt));
          const size_t base = ((size_t)(z * 256 + jt)) * 768;
          DCHK(90, bfv(A2, base + 256 + j), o1 * wf, 0.02f, 1e-3f); DCHK(90, bfv(A2, base + 384 + j), o2 * wf, 0.02f, 1e-3f);
          DCHK(90, bfv(A2, base + 512 + j), o1 * wb, 0.02f, 1e-3f); DCHK(90, bfv(A2, base + 640 + j), o2 * wb, 0.02f, 1e-3f); }
        { float x1 = 0.f, x2 = 0.f; for (int k = 0; k < 1024; ++k) { const float xv = bfv(XN, (size_t)tl * 1024 + k); x1 += xv * bfv(WRI, (size_t)(3072 + h * 256 + j) * 1024 + k); x2 += xv * bfv(WRI, (size_t)(3072 + h * 256 + 128 + j) * 1024 + k); }
          x1 *= rs; x2 *= rs; const float o1 = (x1 * cv - x2 * sv) * 0.0625f, o2 = (x2 * cv + x1 * sv) * 0.0625f;
          DCHK(91, bfv(KB, (size_t)tl * 1024 + h * 256 + j), o1, 0.02f, 1e-3f); DCHK(91, bfv(KB, (size_t)tl * 1024 + h * 256 + 128 + j), o2, 0.02f, 1e-3f);
          const float wf = exp2f(lf * (float)(255 - jt)), wb = exp2f(lb * (float)jt);
          DCHK(92, bfv(KTF, (size_t)(h * 256 + j) * TG + tl), o1 * wf, 0.02f, 1e-3f); DCHK(92, bfv(KTF, (size_t)(h * 256 + 128 + j) * TG + tl), o2 * wf, 0.02f, 1e-3f);
          DCHK(92, bfv(KTB, (size_t)(h * 256 + j) * TG + tl), o1 * wb, 0.02f, 1e-3f); DCHK(92, bfv(KTB, (size_t)(h * 256 + 128 + j) * TG + tl), o2 * wb, 0.02f, 1e-3f); }
        { const int col = (r >> 13) % 2048; float gv = 0.f, vv = 0.f; for (int k = 0; k < 1024; ++k) { const float xv = bfv(XN, (size_t)tl * 1024 + k); gv += xv * bfv(WRI, (size_t)(1024 + col) * 1024 + k); vv += xv * bfv(WRI, (size_t)(4096 + col) * 1024 + k); }
          gv *= rs; vv *= rs; DCHK(93, bfv(SG, (size_t)tl * 2048 + col), gv / (1.0f + expf(-gv)), 0.03f, 2e-3f);
          const int hv = col >> 9, dv = col & 511, zv = (bl * 4 + hv) * 16 + cc; DCHK(94, bfv(BT2, ((size_t)(zv * 512 + dv)) * 768 + jt), vv, 0.02f, 2e-3f); }
    } else if (p == 9) {
        { const int z = r % 128, jn = (r >> 7) % 256, jm = (r >> 15) % 256, bl = z >> 6, h = (z >> 4) & 3, cc = z & 15; float sp = 0.f;
          for (int d = 0; d < 256; ++d) sp += bfv(A2, ((size_t)(z * 256 + jn)) * 768 + 256 + d) * bfv(KB, ((size_t)bl * 4096 + cc * 256 + jm) * 1024 + h * 256 + d);
          const float lf = l2gam(h), lb = l2gam(3 - h); const float f = (jm <= jn) ? exp2f(-lf * (float)(jm + 1)) : exp2f(-lf * (float)(jn + 1) + lb * (float)(jm - jn));
          DCHK(100, bfv(A2, ((size_t)(z * 256 + jn)) * 768 + jm), sp * f, 0.02f, 2e-3f); }
        { const int z = r % 128, dir = (r >> 7) & 1, dv = (r >> 8) % 512, dk = (r >> 17) % 256, bl = z >> 6, h = (z >> 4) & 3, cc = z & 15; float kv = 0.f; const bf16_t* kt = dir ? KTB : KTF;
          for (int m = 0; m < 256; ++m) kv += bfv(BT2, ((size_t)(z * 512 + dv)) * 768 + m) * bfv(kt, (size_t)(h * 256 + dk) * TG + bl * 4096 + cc * 256 + m);
          DCHK(101, bfv(BT2, ((size_t)(z * 512 + dv)) * 768 + 256 + dir * 256 + dk), kv, 0.02f, 2e-3f);
          const int bh = z >> 4; for (int q = 0; q < 16; ++q) dbuf[tid * 16 + q] = bfv(BT2, ((size_t)((bh * 16 + q) * 512 + dv)) * 768 + 256 + dir * 256 + dk); }
    } else if (p == 10) {
        const unsigned r9 = hsh(tid * 7u + 1u + 977u * 9u); const int z = r9 % 128, dir = (r9 >> 7) & 1, dv = (r9 >> 8) % 512, dk = (r9 >> 17) % 256, bh = z >> 4, h = bh & 3;
        const float gch = exp2f(256.0f * l2gam(dir ? 3 - h : h)); float st = 0.f;
        if (dir == 0) { for (int q = 0; q < 16; ++q) { DCHK(110, bfv(BT2, ((size_t)((bh * 16 + q) * 512 + dv)) * 768 + 256 + dk), st, 0.02f, 2e-3f); st = st * gch + dbuf[tid * 16 + q]; } }
        else { for (int q = 15; q >= 0; --q) { DCHK(111, bfv(BT2, ((size_t)((bh * 16 + q) * 512 + dv)) * 768 + 512 + dk), st, 0.02f, 2e-3f); st = st * gch + dbuf[tid * 16 + q]; } }
    } else if (p == 11) {
        const int z = r % 128, jn = (r >> 7) % 256, dv = (r >> 15) % 512, bl = z >> 6, h = (z >> 4) & 3, cc = z & 15, tok = bl * 4096 + cc * 256 + jn; float y = 0.f;
        for (int k = 0; k < 768; ++k) y += bfv(A2, ((size_t)(z * 256 + jn)) * 768 + k) * bfv(BT2, ((size_t)(z * 512 + dv)) * 768 + k);
        DCHK(120, bfv(YZ, (size_t)tok * 2048 + h * 512 + dv), y, 0.02f, 3e-3f);
        float ssq = 0.f; for (int e = 0; e < 512; ++e) { const float v = bfv(YZ, (size_t)tok * 2048 + h * 512 + e); ssq += v * v; }
        DCHK(121, YSS[tok * 4 + h], ssq, 0.03f, 1e-4f);
        dbuf[8192 + tid] = bfv(YZ, (size_t)tok * 2048 + h * 512 + dv);
        if (tid < 64) {
            const float lf = l2gam(h), lb = l2gam(3 - h); const int n = cc * 256 + jn; float acc = 0.f;
            for (int m = 0; m < 4096; ++m) { float qk = 0.f; for (int d = 0; d < 256; ++d) qk += bfv(A2, ((size_t)(z * 256 + jn)) * 768 + 256 + d) * bfv(KB, ((size_t)bl * 4096 + m) * 1024 + h * 256 + d);
                const float w = (m <= n) ? exp2f(lf * (float)(n - m - jn - 1)) : exp2f(lb * (float)(m - n) - lf * (float)(jn + 1));
                const int zm = (bl * 4 + h) * 16 + (m >> 8); acc += qk * w * bfv(BT2, ((size_t)(zm * 512 + dv)) * 768 + (m & 255)); }
            DCHK(125, bfv(YZ, (size_t)tok * 2048 + h * 512 + dv), acc, 0.05f, 1e-2f); }
    } else if (p == 12) {
        const unsigned r11 = hsh(tid * 7u + 1u + 977u * 11u); const int z = r11 % 128, jn = (r11 >> 7) % 256, dv = (r11 >> 15) % 512, bl = z >> 6, h = (z >> 4) & 3, cc = z & 15, tok = bl * 4096 + cc * 256 + jn;
        const float rs = 1.0f / sqrtf(YSS[tok * 4 + h] / 512.0f + EPS);
        DCHK(130, bfv(YZ, (size_t)tok * 2048 + h * 512 + dv), dbuf[8192 + tid] * rs * bfv(SG, (size_t)tok * 2048 + h * 512 + dv), 0.02f, 2e-3f);
    } else if (p == 27) {
        const unsigned r2 = hsh(tid * 7u + 1u + 977u * 28u); const int row2 = r2 % T, col2 = (r2 >> 15) % 1024; dbuf[9216 + tid] = out[(size_t)row2 * 1024 + col2];
    } else if (p == 28) {
        const int row = r % T, col = (r >> 15) % 1024; float ref = dbuf[9216 + tid];
        for (int k = 0; k < 2048; ++k) ref += bfv(YZ, (size_t)row * 2048 + k) * bfv(WRO, (size_t)col * 2048 + k);
        DCHK(140, out[(size_t)row * 1024 + col], ref, 0.01f, 5e-3f);
    } else if (p == 29) {
        const int row = r % T, j = (r >> 15) % FF; float g = 0.f, u = 0.f;
        for (int k = 0; k < 1024; ++k) { const float xv = bfv(XN, (size_t)row * 1024 + k); g += xv * bfv(WFG, (size_t)FF * 1024 + (size_t)j * 1024 + k); u += xv * bfv(WFU, (size_t)FF * 1024 + (size_t)j * 1024 + k); }
        const float rs = 1.0f / sqrtf(SS3[row] / 1024.0f + EPS); g *= rs; u *= rs;
        DCHK(150, bfv(ACT, (size_t)row * FF + j), g / (1.0f + expf(-g)) * u, 0.03f, 5e-3f);
        { const unsigned r2 = hsh(tid * 7u + 1u + 977u * 30u); const int row2 = r2 % T, col2 = (r2 >> 15) % 1024; dbuf[9728 + tid] = out[(size_t)row2 * 1024 + col2]; }
    } else if (p == 30) {
        const int row = r % T, col = (r >> 15) % 1024; float ref = dbuf[9728 + tid];
        for (int k = 0; k < FF; ++k) ref += bfv(ACT, (size_t)row * FF + k) * bfv(WFD, (size_t)FF * 1024 + (size_t)col * FF + k);
        DCHK(160, out[(size_t)row * 1024 + col], ref, 0.01f, 5e-3f);
        { const unsigned r2 = hsh(tid * 7u + 1u + 977u * 31u); const int row2 = r2 % T, col2 = (r2 >> 15) % 1024; dbuf[10240 + tid] = out[(size_t)row2 * 1024 + col2]; }
    } else if (p == 31) {
        const int row = r % T, col = (r >> 15) % 1024;
        DCHK(170, out[(size_t)row * 1024 + col], dbuf[10240 + tid] * (1.0f / sqrtf(SS4[row] / 1024.0f + EPS)) * args.in[3][col], 0.01f, 1e-3f);
    }
}
__global__ void __launch_bounds__(512) dbg_kernel(Args args, int p) { dbg_check(p, args, (int)threadIdx.x); }
__global__ void __launch_bounds__(512) dbg_emit(Args args) { const unsigned code = *(const unsigned*)(args.ws + WS_DBG);
    if (code) for (int i = blockIdx.x * 512 + threadIdx.x; i < T * D; i += gridDim.x * 512) args.out[i] = 10.0f * (float)code; }
#endif

__global__ void __launch_bounds__(512, 2) mk_fwd(Args args) {
    extern __shared__ __attribute__((aligned(16))) unsigned char lds_raw[];
    LAS unsigned char* lds = (LAS unsigned char*)lds_raw;
    cg::grid_group grid = cg::this_grid();
    const int G = gridDim.x, c = blockIdx.x, NGW = G * 8, NGT = G * 512;
#define PH_VARS int tid = threadIdx.x; asm volatile("" : "+v"(tid)); const int lane = tid & 63, wave = __builtin_amdgcn_readfirstlane(tid >> 6), gw = c * 8 + wave, gt = c * 512 + tid; (void)lane; (void)gw; (void)gt;
    unsigned char* ws = args.ws;
    const float* x = args.in[0]; const float* ln_mix = args.in[1]; const float* ln_ffn = args.in[2]; const float* ln_fin = args.in[3];
    float* out = args.out;
#ifdef DBG
    const int lo = args.ph_lo, hi = args.ph_hi;
    int p = 0;
#endif
#define PH_ON (p >= lo && p < hi)
    volatile LAS unsigned* MISC = (volatile LAS unsigned*)(lds + MISC_OFF);
    if (threadIdx.x < 32) MISC[threadIdx.x] = 0u;
    __syncthreads();
    XcdBarrier xbar; xbar.bar = (unsigned*)(ws + WS_BAR); xbar.x = 0; xbar.st = MISC + 8;
#ifndef DBG
    xbar = xcd_barrier_post((unsigned*)(ws + WS_BAR), MISC + 8);
    if (args.ph_lo < 0) grid.sync();
#endif
#ifdef DBG
#define PH_END do { if (PH_ON && p + 1 < hi) { if (p == 0) { grid.sync(); xbar = xcd_barrier_post((unsigned*)(ws + WS_BAR), MISC + 8); } else xcd_barrier(xbar); } ++p; } while (0)
#define PH_END0 PH_END
#define PH_FINAL PH_END
#else
#undef PH_ON
#define PH_ON true
#define PH_END0 xcd_barrier(xbar)
#define PH_END xcd_barrier(xbar)
#define PH_FINAL do { } while (0)
#endif

    for (int rep_ = 0; rep_ < ((PH_ON && PHX(0)) ? NREP(0) : 0); ++rep_) { PH_VARS
#ifdef DBG
        if (gt == 0) *(unsigned*)(ws + WS_DBG) = 0u;
#endif
#ifdef DBG
        if (gt < XCD_BAR_WORDS) ((unsigned*)(ws + WS_BAR))[gt] = 0u;
#endif
        for (int i = gt; i < 4096 * 128; i += NGT) { const int pos = i >> 7, j = i & 127;
            const float invf = ex2(-(float)j * (13.287712379549449f / 127.0f)); const float ang = (float)pos * invf;
            double rd = (double)ang * 0.15915494309189535; rd -= floor(rd); const float fr_ = (float)rd;
            COST[i] = __builtin_amdgcn_cosf(fr_); SINT[i] = __builtin_amdgcn_sinf(fr_); }
        for (int i = gt; i < 4096 * 128; i += NGT) { const int j = i >> 12, pos = i & 4095;
            const float invf = ex2(-(float)j * (13.287712379549449f / 127.0f)); const float ang = (float)pos * invf;
            double rd = (double)ang * 0.15915494309189535; rd -= floor(rd); const float fr_ = (float)rd;
            COSJ[i] = __builtin_amdgcn_cosf(fr_); SINJ[i] = __builtin_amdgcn_sinf(fr_); }
        for (int i = gt; i < 2048; i += NGT) { const float lam = args.in[11][i]; CLA[i] = -8.0f * log1pf(expf(-lam)) * 1.4426950408889634f; }
        LAS float* scr = (LAS float*)(lds + wave * 16384);
#define TR_DECODE(IT0, W, ldw, K, N, WT, gain, it) do { it = (IT0); gain = nullptr; \
            if (it < 1024) { W = args.in[4]; ldw = 2048; K = 1024; N = 2048; WT = WIN; } \
            else if ((it -= 1024) < 512) { const int mat = it >> 5; it &= 31; W = (mat < 8 ? args.in[7] : args.in[9]) + (size_t)(mat & 7) * 65536; WT = (mat < 8 ? WGA : WGX) + (size_t)(mat & 7) * 65536; ldw = 256; K = 256; N = 256; } \
            else if ((it -= 512) < 512) { W = args.in[12]; ldw = 1024; K = 1024; N = 1024; WT = WLO; } \
            else if ((it -= 512) < 8448) { const int q = it / 1408; it -= q * 1408; const int l = q / 3, w = q - l * 3; \
                if (w == 0) { W = args.in[15] + (size_t)l * 1024 * FF; ldw = FF; K = 1024; N = FF; WT = WFG + (size_t)l * FF * 1024; gain = ln_ffn + l * 1024; } \
                else if (w == 1) { W = args.in[16] + (size_t)l * 1024 * FF; ldw = FF; K = 1024; N = FF; WT = WFU + (size_t)l * FF * 1024; gain = ln_ffn + l * 1024; } \
                else { W = args.in[17] + (size_t)l * 1024 * FF; ldw = 1024; K = FF; N = 1024; WT = WFD + (size_t)l * FF * 1024; } } \
            else if ((it -= 8448) < 3072) { ldw = 6144; K = 1024; gain = ln_mix + 1024; \
                if (it < 512) { W = args.in[13]; N = 1024; WT = WRI; } \
                else if ((it -= 512) < 512) { W = args.in[13] + 1024; N = 1024; WT = WRI + (size_t)3072 * 1024; } \
                else if ((it -= 512) < 1024) { W = args.in[13] + 2048; N = 2048; WT = WRI + (size_t)4096 * 1024; } \
                else { it -= 1024; W = args.in[13] + 4096; N = 2048; WT = WRI + (size_t)1024 * 1024; } } \
            else { it -= 3072; W = args.in[14]; ldw = 1024; K = 2048; N = 1024; WT = WRO; } } while (0)
        if (gw < 14592) {
            const float* W; const float* gain; bf16_t* WT; int ldw, K, N, it; f32x4 v[8];
            TR_DECODE(gw, W, ldw, K, N, WT, gain, it); tr_load(W, ldw, N / 32, it, lane, v);
            for (int it0 = gw; it0 < 14592; it0 += NGW) {
                const float* W2 = W; const float* gain2 = gain; bf16_t* WT2 = WT; int ldw2 = ldw, K2 = K, N2 = N, it2 = it; f32x4 v2[8];
                const bool more = it0 + NGW < 14592;
                if (more) { TR_DECODE(it0 + NGW, W2, ldw2, K2, N2, WT2, gain2, it2); tr_load(W2, ldw2, N2 / 32, it2, lane, v2); }
                tr_finish(v, K, N / 32, WT, scr, it, lane, gain);
                if (more) { W = W2; gain = gain2; WT = WT2; ldw = ldw2; K = K2; N = N2; it = it2;
#pragma unroll
                    for (int i = 0; i < 8; ++i) v[i] = v2[i]; }
            }
        }
#undef TR_DECODE
        for (int row = gw; row < T; row += 2 * NGW) {
            const int row2 = row + NGW; const bool has2 = row2 < T;
            const f32x4* xr = (const f32x4*)(x + (size_t)row * 1024) + lane; const f32x4* xr2 = (const f32x4*)(x + (size_t)(has2 ? row2 : row) * 1024) + lane;
            f32x4 v[4], v2[4]; float s = 0.f, s2 = 0.f;
#pragma unroll
            for (int j = 0; j < 4; ++j) { v[j] = xr[64 * j]; v2[j] = xr2[64 * j]; }
#pragma unroll
            for (int j = 0; j < 4; ++j) { s += (v[j][0] * v[j][0] + v[j][1] * v[j][1]) + (v[j][2] * v[j][2] + v[j][3] * v[j][3]); s2 += (v2[j][0] * v2[j][0] + v2[j][1] * v2[j][1]) + (v2[j][2] * v2[j][2] + v2[j][3] * v2[j][3]); }
            const float rs = rsq(wave_sum(s) * (1.0f / 1024.0f) + EPS), rs2 = rsq(wave_sum(s2) * (1.0f / 1024.0f) + EPS);
#pragma unroll
            for (int j = 0; j < 4; ++j) { const f32x4 gv = ((const f32x4*)ln_mix)[64 * j + lane]; const f32x4 o = v[j] * rs * gv, o2 = v2[j] * rs2 * gv;
                uint2 w; w.x = cvt_pk_bf16(o[0], o[1]); w.y = cvt_pk_bf16(o[2], o[3]); *(uint2*)(XN + (size_t)row * 1024 + (64 * j + lane) * 4) = w;
                if (has2) { uint2 w2; w2.x = cvt_pk_bf16(o2[0], o2[1]); w2.y = cvt_pk_bf16(o2[2], o2[3]); *(uint2*)(XN + (size_t)row2 * 1024 + (64 * j + lane) * 4) = w2; } }
        }
    }
    PH_END0;

    for (int rep_ = 0; rep_ < ((PH_ON && PHX(1)) ? NREP(1) : 0); ++rep_) {
        StdSched S{(const char*)XN, (const char*)WIN, 128, 8, 1024, 1024, G, c}; EpiP1 E{XBP, GG};
        pg8::gemm_phase(lds, 1024, 1024, 1024, S, E);
    }
    PH_END;

#ifdef EXTRA_BAR
    for (int eb_ = 0; eb_ < EXTRA_BAR; ++eb_) xcd_barrier(xbar);
#endif
    for (int rep_ = 0; rep_ < ((PH_ON && PHX(2)) ? NREP(2) : 0); ++rep_) { PH_VARS
        const float* cw = args.in[5]; const float* cb = args.in[6];
        for (int it = gt; it < 1024 * 128; it += NGT) {
            const int o = it & 127, s = it >> 7, t0 = s * 32, ch = o * 8, p0 = t0 & 4095;
            f32x4 w[4][2];
#pragma unroll
            for (int j = 0; j < 4; ++j) { w[j][0] = *(const f32x4*)(cw + j * 1024 + ch); w[j][1] = *(const f32x4*)(cw + j * 1024 + ch + 4); }
            const f32x4 b0 = *(const f32x4*)(cb + ch), b1 = *(const f32x4*)(cb + ch + 4);
            const bf16_t* src = XBP + (size_t)t0 * 1024 + ch; bf16_t* dst = XB + (size_t)t0 * 1024 + ch;
            const f32x4 zz = (f32x4){0.f, 0.f, 0.f, 0.f};
            f32x4 m2l = zz, m2h = zz, m1l = zz, m1h = zz, c0l, c0h;
            if (p0 != 0) { const u32x4 a = *(const u32x4*)(src - 2048), bq = *(const u32x4*)(src - 1024); m2l = unlo(a); m2h = unhi(a); m1l = unlo(bq); m1h = unhi(bq); }
            { const u32x4 a = *(const u32x4*)(src); c0l = unlo(a); c0h = unhi(a); }
#pragma unroll 8
            for (int i = 0; i < 32; ++i) {
                f32x4 p1l = zz, p1h = zz;
                if (p0 + i + 1 < 4096) { const u32x4 a = *(const u32x4*)(src + (size_t)(i + 1) * 1024); p1l = unlo(a); p1h = unhi(a); }
                const f32x4 yl = w[0][0] * m2l + w[1][0] * m1l + w[2][0] * c0l + w[3][0] * p1l + b0;
                const f32x4 yh = w[0][1] * m2h + w[1][1] * m1h + w[2][1] * c0h + w[3][1] * p1h + b1;
                ST16((dst + (size_t)i * 1024), pack8(yl, yh));
                m2l = m1l; m2h = m1h; m1l = c0l; m1h = c0h; c0l = p1l; c0h = p1h;
            }
        }
    }
    PH_END;

    for (int rep_ = 0; rep_ < ((PH_ON && PHX(3)) ? NREP(3) : 0); ++rep_) {
        GateSched S{(const char*)XB, (const char*)WGA, (const char*)WGX, G, c};
        EpiGate E{XB, args.in[8], args.in[10], CLA, LAF, INF, LAB, INB};
        pg8::gemm_phase(lds, 1024, 256, 256, S, E);
    }
    PH_END;

    for (int rep_ = 0; rep_ < ((PH_ON && PHX(4)) ? NREP(4) : 0); ++rep_) { PH_VARS
        const int o = tid & 3, s = tid >> 2;
        LAS float* CL = (LAS float*)lds; LAS float* CH = CL + 2 * 128 * 32;
        for (int it_ = c; it_ < 256; it_ += G) {
            const int item = (G == 256) ? ((it_ & 7) * 32 + (it_ >> 3)) : it_;
            const size_t slab = (size_t)item * 4096 * 32 + o * 8; const int b = item >> 5, cgp = item & 31;
            float L[8], H[8];
#pragma unroll
            for (int dir = 0; dir < 2; ++dir) {
#pragma unroll
                for (int k = 0; k < 8; ++k) { L[k] = 0.f; H[k] = 0.f; }
                const unsigned short* pl = (dir ? LAB : LAF) + slab + (size_t)s * 1024; const bf16_t* pq = (dir ? INB : INF) + slab + (size_t)s * 1024;
                asm volatile("" : "+v"(pl), "+v"(pq));
                u32x4 lbuf[2][4], qbuf[2][4];
#pragma unroll
                for (int j = 0; j < 4; ++j) { const int r0 = (dir ? 28 : 0) + j; lbuf[0][j] = *(const u32x4*)(pl + r0 * 32); qbuf[0][j] = *(const u32x4*)(pq + r0 * 32); }
#pragma unroll
                for (int gi = 0; gi < 8; ++gi) { const int gg_ = dir ? 7 - gi : gi;
                    if (gi < 7) { const int gn = dir ? gg_ - 1 : gg_ + 1;
#pragma unroll
                        for (int j = 0; j < 4; ++j) { lbuf[(gi + 1) & 1][j] = *(const u32x4*)(pl + (gn * 4 + j) * 32); qbuf[(gi + 1) & 1][j] = *(const u32x4*)(pq + (gn * 4 + j) * 32); } }
#pragma unroll
                    for (int jj = 0; jj < 4; ++jj) { const int j = dir ? 3 - jj : jj; const u32x4 lw = lbuf[gi & 1][j], iw = qbuf[gi & 1][j];
                        const f32x4 l0 = unlo_h(lw), l1 = unhi_h(lw), q0 = unlo(iw), q1 = unhi(iw);
#pragma unroll
                        for (int k = 0; k < 4; ++k) { lru_step(l0[k], q0[k], H[k]); L[k] += l0[k]; lru_step(l1[k], q1[k], H[4 + k]); L[4 + k] += l1[k]; } }
                    __builtin_amdgcn_sched_barrier(0); }
#pragma unroll
                for (int k = 0; k < 8; ++k) { CL[(dir * 128 + s) * 32 + o * 8 + k] = L[k]; CH[(dir * 128 + s) * 32 + o * 8 + k] = H[k]; }
            }
            __syncthreads();
#ifdef DBG
            if (item == 0) { float* dc = (float*)(ws + WS_DBGBUF) + 32768;
#pragma unroll
                for (int k = 0; k < 8; ++k) { dc[s * 32 + o * 8 + k] = CL[s * 32 + o * 8 + k]; dc[4096 + s * 32 + o * 8 + k] = CH[s * 32 + o * 8 + k]; } }
            __syncthreads();
#endif
            if (tid < 64) { const int dir = tid >> 5, ch = tid & 31; float cr = 0.f;
                if (dir == 0) { for (int q = 0; q < 128; ++q) { const int idx = q * 32 + ch; const float l = CL[idx], hh = CH[idx]; CH[idx] = cr; cr = ex2(l) * cr + hh; } }
                else { for (int q = 127; q >= 0; --q) { const int idx = (128 + q) * 32 + ch; const float l = CL[idx], hh = CH[idx]; CH[idx] = cr; cr = ex2(l) * cr + hh; } } }
            __syncthreads();
#ifdef DBG
            if (item == 0) { float* dc = (float*)(ws + WS_DBGBUF) + 16384;
#pragma unroll
                for (int k = 0; k < 8; ++k) { dc[s * 32 + o * 8 + k] = CH[s * 32 + o * 8 + k]; dc[4096 + s * 32 + o * 8 + k] = CH[(128 + s) * 32 + o * 8 + k]; } }
#endif
#pragma unroll
            for (int k = 0; k < 8; ++k) H[k] = CH[s * 32 + o * 8 + k];
            u32x4 hfp[32];
            {
                const unsigned short* pl = LAF + slab + (size_t)s * 1024; const bf16_t* pi = INF + slab + (size_t)s * 1024;
                asm volatile("" : "+v"(pl), "+v"(pi));
                u32x4 lbuf[2][4], qbuf[2][4];
#pragma unroll
                for (int j = 0; j < 4; ++j) { lbuf[0][j] = *(const u32x4*)(pl + j * 32); qbuf[0][j] = *(const u32x4*)(pi + j * 32); }
#pragma unroll
                for (int gi = 0; gi < 8; ++gi) {
                    if (gi < 7) {
#pragma unroll
                        for (int j = 0; j < 4; ++j) { lbuf[(gi + 1) & 1][j] = *(const u32x4*)(pl + ((gi + 1) * 4 + j) * 32); qbuf[(gi + 1) & 1][j] = *(const u32x4*)(pi + ((gi + 1) * 4 + j) * 32); } }
#pragma unroll
                    for (int j = 0; j < 4; ++j) { const u32x4 lw = lbuf[gi & 1][j], iw = qbuf[gi & 1][j];
                        const f32x4 l0 = unlo_h(lw), l1 = unhi_h(lw), q0 = unlo(iw), q1 = unhi(iw); f32x4 h0, h1;
#pragma unroll
                        for (int k = 0; k < 4; ++k) { lru_step(l0[k], q0[k], H[k]); lru_step(l1[k], q1[k], H[4 + k]); h0[k] = H[k]; h1[k] = H[4 + k]; }
                        hfp[gi * 4 + j] = pack8(h0, h1); }
                    __builtin_amdgcn_sched_barrier(0); }
            }
#pragma unroll
            for (int k = 0; k < 8; ++k) H[k] = CH[(128 + s) * 32 + o * 8 + k];
            {
                const unsigned short* pl = LAB + slab + (size_t)s * 1024; const bf16_t* pi = INB + slab + (size_t)s * 1024; const bf16_t* pg = GG + slab + (size_t)s * 1024;
                bf16_t* yp = YL + (size_t)(b * 4096 + s * 32 + 31) * 1024 + cgp * 32 + o * 8;
                asm volatile("" : "+v"(pl), "+v"(pi), "+v"(pg), "+v"(yp));
                u32x4 lbuf[2][2], qbuf[2][2], gbuf[2][2];
#pragma unroll
                for (int j = 0; j < 2; ++j) { lbuf[0][j] = *(const u32x4*)(pl + (30 + j) * 32); qbuf[0][j] = *(const u32x4*)(pi + (30 + j) * 32); gbuf[0][j] = *(const u32x4*)(pg + (30 + j) * 32); }
#pragma unroll
                for (int gi = 0; gi < 16; ++gi) { const int g2 = 15 - gi;
                    if (gi < 15) {
#pragma unroll
                        for (int j = 0; j < 2; ++j) { const int r_ = (g2 - 1) * 2 + j; lbuf[(gi + 1) & 1][j] = *(const u32x4*)(pl + r_ * 32); qbuf[(gi + 1) & 1][j] = *(const u32x4*)(pi + r_ * 32); gbuf[(gi + 1) & 1][j] = *(const u32x4*)(pg + r_ * 32); } }
#pragma unroll
                    for (int jj = 0; jj < 2; ++jj) { const int j = 1 - jj, i = g2 * 2 + j; const u32x4 lw = lbuf[gi & 1][j], iw = qbuf[gi & 1][j], gwv = gbuf[gi & 1][j], fw = hfp[i];
                        const f32x4 l0 = unlo_h(lw), l1 = unhi_h(lw), q0 = unlo(iw), q1 = unhi(iw), g0 = unlo(gwv), g1 = unhi(gwv), f0 = unlo(fw), f1 = unhi(fw); f32x4 y0, y1;
#pragma unroll
                        for (int k = 0; k < 4; ++k) { lru_step(l0[k], q0[k], H[k]); lru_step(l1[k], q1[k], H[4 + k]); y0[k] = (f0[k] + H[k]) * g0[k]; y1[k] = (f1[k] + H[4 + k]) * g1[k]; }
                        ST16(yp, pack8(y0, y1)); yp -= 1024; asm volatile("" : "+v"(yp)); }
                    if (gi & 1) __builtin_amdgcn_sched_barrier(0); }
            }
            __syncthreads();
        }
    }
    PH_END;

    for (int rep_ = 0; rep_ < ((PH_ON && PHX(5)) ? NREP(5) : 0); ++rep_) {
        StdSched S{(const char*)YL, (const char*)WLO, 128, 4, 1024, 1024, G, c}; EpiRes<true> E{x, XN, SS1, nullptr};
        pg8::gemm_phase(lds, 1024, 1024, 1024, S, E);
    }
    PH_END;
    for (int rep_ = 0; rep_ < ((PH_ON && PHX(6)) ? NREP(6) : 0); ++rep_) {
        FfnUpSched S{(const char*)XN, (const char*)WFG, (const char*)WFU, G, c}; EpiFfnUp E{SS1, ACT};
        pg8::gemm_phase(lds, 1024, 1024, 1024, S, E);
    }
    PH_END;
    for (int rep_ = 0; rep_ < ((PH_ON && PHX(7)) ? NREP(7) : 0); ++rep_) {
        StdSched S{(const char*)ACT, (const char*)WFD, 128, 4, FF, FF, G, c}; EpiRes<false> E{nullptr, XN, SS2, nullptr};
        pg8::gemm_phase(lds, FF, FF, FF, S, E);
    }
    PH_END;

#define NORM_PASS(gg) do { _Pragma("unroll 4") for (int it = gt; it < TG * 256; it += NGT) { const int row = it >> 8, o = it & 255, h = o >> 6; const int tok = (gg) * TG + row; \
        const float* yq_ = YSS + (size_t)(tok * 4 + h) * 8; const f32x4 ya_ = *(const f32x4*)yq_ + *(const f32x4*)(yq_ + 4); const float rs = rsq(((ya_[0] + ya_[1]) + (ya_[2] + ya_[3])) * (1.0f / 512.0f) + EPS); bf16_t* yp = YZ + (size_t)tok * 2048 + o * 8; const u32x4 yw = *(const u32x4*)yp; \
        ST16(yp, pack8(unlo(yw) * rs, unhi(yw) * rs)); } } while (0)
    for (int g = 0; g < NGRP; ++g) {
        const bf16_t* XNg = XN + (size_t)g * TG * 1024;
        for (int rep_ = 0; rep_ < ((PH_ON && PHX(8)) ? NREP(8) : 0); ++rep_) {
            { RetProjSched S{(const char*)XNg, (const char*)WRI, G, c}; EpiRetAB E{EpiRetA{SS2, COST, SINT, A2, SG, KB, g}, EpiRetB{SS2, BT2, g}};
              pg8::gemm_phase(lds, 1024, 1024, 1024, S, E); }
        }
        PH_END;
        for (int rep_ = 0; rep_ < ((PH_ON && PHX(9)) ? NREP(9) : 0); ++rep_) {
            { ScoreSched S{(const char*)A2, (const char*)KB, G, c}; EpiScore E{A2}; pg8::gemm_phase(lds, 768, 1024, 256, S, E); }
            const bool split = G >= 256;
            if (!split || c >= 128) { PH_VARS
                const int w0 = split ? (c - 128) * 8 + wave : gw, wst = split ? (G - 128) * 8 : NGW;
                LAS bf16_t* tb = (LAS bf16_t*)(lds + wave * 16384);
                for (int tile = w0; tile < 128 * 16; tile += wst) {
                    const int t0 = (tile >> 4) * 64, d0 = (tile & 15) * 64, h = d0 >> 8; const float lf = l2gam(h), lb = l2gam(3 - h);
#pragma unroll
                    for (int i = 0; i < 8; ++i) { const int row = i * 8 + (lane >> 3), cp = lane & 7;
                        *(LAS u32x4*)(tb + row * 72 + cp * 8) = *(const u32x4*)(KB + (size_t)(t0 + row) * 1024 + d0 + cp * 8); }
                    asm volatile("s_waitcnt lgkmcnt(0)" ::: "memory");
                    const int tp = lane & 7, jt0 = (t0 & 255) + tp * 8;
                    f32x4 wf0, wf1, wb0, wb1;
#pragma unroll
                    for (int e = 0; e < 4; ++e) { wf0[e] = ex2(lf * (float)(255 - (jt0 + e))); wf1[e] = ex2(lf * (float)(255 - (jt0 + 4 + e))); wb0[e] = ex2(lb * (float)(jt0 + e)); wb1[e] = ex2(lb * (float)(jt0 + 4 + e)); }
#pragma unroll
                    for (int i = 0; i < 8; ++i) { const int col = i * 8 + (lane >> 3); f32x4 k0, k1;
#pragma unroll
                        for (int e = 0; e < 4; ++e) { k0[e] = __uint_as_float((unsigned)tb[(tp * 8 + e) * 72 + col] << 16); k1[e] = __uint_as_float((unsigned)tb[(tp * 8 + 4 + e) * 72 + col] << 16); }
                        const size_t o = (size_t)(d0 + col) * TG + t0 + tp * 8;
                        ST16((KTF + o), pack8(k0 * wf0, k1 * wf1)); ST16((KTB + o), pack8(k0 * wb0, k1 * wb1)); }
                    asm volatile("s_waitcnt lgkmcnt(0)" ::: "memory");
                }
            }
        }
        PH_END;
        for (int rep_ = 0; rep_ < ((PH_ON && PHX(12)) ? NREP(12) : 0); ++rep_) {
            KvSched S{(const char*)BT2, (const char*)KTF, (const char*)KTB, G, c}; EpiKv E{BT2}; pg8::gemm_phase(lds, 768, TG, 256, S, E);
        }
        PH_END;
        for (int rep_ = 0; rep_ < ((PH_ON && PHX(10)) ? NREP(10) : 0); ++rep_) { PH_VARS
            for (int it = gt; it < 262144; it += NGT) {
                const int ok = it & 31, dv = (it >> 5) & 511, dir = (it >> 14) & 1, bh = it >> 15, h = bh & 3;
                const float gch = ex2(256.0f * l2gam(dir ? 3 - h : h));
                bf16_t* pb = BT2 + ((size_t)(bh * 16) * 512 + dv) * 768 + 256 + dir * 256 + ok * 8;
                u32x4 v[16];
#pragma unroll
                for (int q = 0; q < 16; ++q) v[q] = *(const u32x4*)(pb + (size_t)q * 512 * 768);
                f32x4 s0 = (f32x4){0.f, 0.f, 0.f, 0.f}, s1 = s0;
                if (dir == 0) {
#pragma unroll
                    for (int q = 0; q < 16; ++q) { ST16((pb + (size_t)q * 512 * 768), pack8(s0, s1)); s0 = s0 * gch + unlo(v[q]); s1 = s1 * gch + unhi(v[q]); }
                } else {
#pragma unroll
                    for (int q = 15; q >= 0; --q) { ST16((pb + (size_t)q * 512 * 768), pack8(s0, s1)); s0 = s0 * gch + unlo(v[q]); s1 = s1 * gch + unhi(v[q]); }
                }
            }
        }
        PH_END;
        for (int rep_ = 0; rep_ < ((PH_ON && PHX(11)) ? NREP(11) : 0); ++rep_) {
            YSched S{(const char*)A2, (const char*)BT2, G, c}; EpiY E{YZ, YSS, SG, g}; pg8::gemm_phase(lds, 768, 768, 768, S, E);
        }
        PH_END;
    }
    for (int rep_ = 0; rep_ < (PH_ON ? 1 : 0); ++rep_) { PH_VARS
        float* RQ = (float*)(ws + WS_RQ);
        for (int tok = gt; tok < T; tok += NGT) { float rsv[4];
#pragma unroll
            for (int h = 0; h < 4; ++h) { const float* yq_ = YSS + (size_t)(tok * 4 + h) * 8; const f32x4 ya_ = *(const f32x4*)yq_ + *(const f32x4*)(yq_ + 4);
                rsv[h] = rsq(((ya_[0] + ya_[1]) + (ya_[2] + ya_[3])) * (1.0f / 512.0f) + EPS); }
            *(f32x4*)(RQ + (size_t)tok * 4) = (f32x4){rsv[0] / rsv[1], rsv[1] / rsv[2], rsv[2] / rsv[3], rsv[3]}; }
    }
    PH_END;
    for (int rep_ = 0; rep_ < ((PH_ON && PHX(13)) ? NREP(13) : 0); ++rep_) {
        StdSched S{(const char*)YZ, (const char*)WRO, 128, 4, 2048, 2048, G, c}; EpiRes<false, true> E{nullptr, XN, SS3, (const float*)(ws + WS_RQ)};
        pg8::gemm_phase(lds, 2048, 2048, 2048, S, E, pg8::HeadRescale{(const float*)(ws + WS_RQ)});
    }
    PH_END;
    for (int rep_ = 0; rep_ < ((PH_ON && PHX(14)) ? NREP(14) : 0); ++rep_) {
        FfnUpSched S{(const char*)XN, (const char*)(WFG + (size_t)FF * 1024), (const char*)(WFU + (size_t)FF * 1024), G, c}; EpiFfnUp E{SS3, ACT};
        pg8::gemm_phase(lds, 1024, 1024, 1024, S, E);
    }
    PH_END;
    for (int rep_ = 0; rep_ < ((PH_ON && PHX(15)) ? NREP(15) : 0); ++rep_) {
        StdSched S{(const char*)ACT, (const char*)(WFD + (size_t)FF * 1024), 128, 4, FF, FF, G, c}; EpiRes<false> E{nullptr, XN, SS4, nullptr};
        pg8::gemm_phase(lds, FF, FF, FF, S, E);
    }
    PH_END;
    for (int rep_ = 0; rep_ < ((PH_ON && PHX(16)) ? NREP(16) : 0); ++rep_) { PH_VARS
        for (int row = gw; row < T; row += 2 * NGW) { const int row2 = row + NGW < T ? row + NGW : row;
            const f32x4* sp = (const f32x4*)(SS4 + (size_t)row * 16); const f32x4* sp2 = (const f32x4*)(SS4 + (size_t)row2 * 16);
            const f32x4 a0 = sp[0], a1 = sp[1], a2_ = sp[2], a3 = sp[3], b0 = sp2[0], b1 = sp2[1], b2_ = sp2[2], b3 = sp2[3];
            const uint2* hrow = (const uint2*)(XN + (size_t)row * 1024) + lane; const uint2* hrow2 = (const uint2*)(XN + (size_t)row2 * 1024) + lane;
            uint2 hw[4], hw2[4];
#pragma unroll
            for (int j = 0; j < 4; ++j) { hw[j] = hrow[64 * j]; hw2[j] = hrow2[64 * j]; }
            const f32x4 sa = (a0 + a1) + (a2_ + a3), sb = (b0 + b1) + (b2_ + b3);
            const float rs = rsq(((sa[0] + sa[1]) + (sa[2] + sa[3])) * (1.0f / 1024.0f) + EPS), rs2 = rsq(((sb[0] + sb[1]) + (sb[2] + sb[3])) * (1.0f / 1024.0f) + EPS);
            f32x4* orow = (f32x4*)(out + (size_t)row * 1024) + lane; f32x4* orow2 = (f32x4*)(out + (size_t)row2 * 1024) + lane;
#pragma unroll
            for (int j = 0; j < 4; ++j) { const f32x4 gv = ((const f32x4*)ln_fin)[64 * j + lane];
                f32x4 hv; hv[0] = __uint_as_float(hw[j].x << 16); hv[1] = __uint_as_float(hw[j].x & 0xffff0000u); hv[2] = __uint_as_float(hw[j].y << 16); hv[3] = __uint_as_float(hw[j].y & 0xffff0000u);
                orow[64 * j] = hv * rs * gv;
                if (row2 != row) { f32x4 hv2; hv2[0] = __uint_as_float(hw2[j].x << 16); hv2[1] = __uint_as_float(hw2[j].x & 0xffff0000u); hv2[2] = __uint_as_float(hw2[j].y << 16); hv2[3] = __uint_as_float(hw2[j].y & 0xffff0000u);
                    orow2[64 * j] = hv2 * rs2 * gv; } } }
    }
    PH_FINAL;
}
constexpr int N_PHASES = 8 + 5 * NGRP + 1 + 4;

extern "C" void kernel_launch(void* const* d_in, const int* in_sizes, int n_in, void* d_out, int out_size, void* d_ws, size_t ws_size, hipStream_t stream) {
    static int grid = 0;
    if (grid == 0) {
        if (n_in != 18 || out_size != T * D || ws_size < WS_END) { fprintf(stderr, "kernel_launch: unexpected shapes (n_in %d out %d ws %zu)\n", n_in, out_size, ws_size); grid = -1; return; }
        int dev = 0, cus = 0, per_cu = 0;
        hipGetDevice(&dev); hipDeviceGetAttribute(&cus, hipDeviceAttributeMultiprocessorCount, dev);
        hipFuncSetAttribute((const void*)mk_fwd, hipFuncAttributeMaxDynamicSharedMemorySize, LDS_BYTES);
        hipOccupancyMaxActiveBlocksPerMultiprocessor(&per_cu, (const void*)mk_fwd, 512, LDS_BYTES);
        if (per_cu < 1) { fprintf(stderr, "kernel_launch: occupancy query says %d blocks/CU\n", per_cu); grid = -1; return; }
        grid = cus;
        (void)hipGetLastError();
    }
    if (grid < 0) return;
    Args a{};
    for (int i = 0; i < 18; ++i) a.in[i] = (const float*)d_in[i];
    a.out = (float*)d_out; a.ws = (unsigned char*)d_ws; a.ph_lo = 0; a.ph_hi = N_PHASES;
    void* kargs[] = {&a};
#ifdef DBG
    for (int ph = 0; ph < N_PHASES; ++ph) { a.ph_lo = ph; a.ph_hi = ph + 1;
        hipError_t e = hipLaunchCooperativeKernel((const void*)mk_fwd, dim3(grid), dim3(512), kargs, LDS_BYTES, stream);
        if (e != hipSuccess) fprintf(stderr, "cooperative launch failed: %s (grid %d)\n", hipGetErrorString(e), grid);
        hipLaunchKernelGGL(dbg_kernel, dim3(1), dim3(512), 0, stream, a, ph); }
    hipLaunchKernelGGL(dbg_emit, dim3(1024), dim3(512), 0, stream, a);
#else
    (void)hipMemsetAsync((unsigned char*)d_ws + WS_BAR, 0, XCD_BAR_WORDS * 4, stream);
    hipError_t e = hipLaunchCooperativeKernel((const void*)mk_fwd, dim3(grid), dim3(512), kargs, LDS_BYTES, stream);
    if (e != hipSuccess) fprintf(stderr, "cooperative launch failed: %s (grid %d)\n", hipGetErrorString(e), grid);
#endif
}
```

```cpp
#include <hip/hip_runtime.h>
#include <hip/hip_cooperative_groups.h>
#include <cstdio>
#include <cstdint>
namespace cg = cooperative_groups;

#define LAS __attribute__((address_space(3)))
typedef unsigned short bf16_t;
typedef short bf16x8 __attribute__((ext_vector_type(8)));
typedef float f32x4 __attribute__((ext_vector_type(4)));
typedef unsigned u32x4 __attribute__((ext_vector_type(4)));
typedef _Float16 half2_t __attribute__((ext_vector_type(2)));

constexpr int T = 32768, D = 1024, SEQ = 4096, FF = 2816, NGRP = 4, TG = 8192;
constexpr float EPS = 1e-6f;
constexpr size_t MiB = 1u << 20;
constexpr size_t WS_SS1 = 484 * MiB, WS_SS2 = 486 * MiB, WS_SS3 = 488 * MiB, WS_SS4 = 490 * MiB, WS_YSS = 492 * MiB;
constexpr size_t WS_RQ = 0;
constexpr size_t WS_COST = 1 * MiB, WS_SINT = 3 * MiB, WS_COSJ = 5 * MiB, WS_SINJ = 7 * MiB, WS_CLA = 9 * MiB;
constexpr size_t WS_WIN = 10 * MiB, WS_WGA = 14 * MiB, WS_WGX = 15 * MiB, WS_WLO = 16 * MiB, WS_WFG = 18 * MiB, WS_WFU = 29 * MiB,
                 WS_WFD = 40 * MiB, WS_WRI = 51 * MiB, WS_WRO = 63 * MiB;
constexpr size_t WS_XN = 68 * MiB;
constexpr size_t WS_XBP = 132 * MiB, WS_GG = 196 * MiB, WS_XB = 260 * MiB, WS_LAF = 68 * MiB, WS_INF = 132 * MiB, WS_LAB = 324 * MiB,
                 WS_INB = 388 * MiB, WS_YL = 260 * MiB;
constexpr size_t WS_ACT = 132 * MiB;
constexpr size_t WS_YZ = 132 * MiB, WS_A2 = 260 * MiB, WS_KB = 308 * MiB, WS_KTF = 324 * MiB, WS_KTB = 340 * MiB, WS_BT2 = 356 * MiB,
                 WS_SG = 452 * MiB, WS_END = 496 * MiB;
constexpr int LDS_BYTES = 147456;

__device__ __forceinline__ float l2gam(int h) {
    return h == 0 ? -0.04580368961312479f : (h == 1 ? -0.02272007650008353f : (h == 2 ? -0.011315313227834146f : -0.005646563141142063f));
}
__device__ __forceinline__ float ex2(float x) { return __builtin_amdgcn_exp2f(x); }
__device__ __forceinline__ float rcpf_(float x) { return __builtin_amdgcn_rcpf(x); }
__device__ __forceinline__ float sigm(float x) { return rcpf_(1.0f + ex2(-1.4426950408889634f * x)); }
__device__ __forceinline__ float rsq(float x) { return __builtin_amdgcn_rsqf(x); }
__device__ __forceinline__ unsigned cvt_pk_bf16(float lo, float hi) { unsigned r; asm volatile("v_cvt_pk_bf16_f32 %0, %1, %2" : "=v"(r) : "v"(lo), "v"(hi)); return r; }
__device__ __forceinline__ u32x4 pack8(f32x4 a, f32x4 b) { u32x4 w; w.x = cvt_pk_bf16(a[0], a[1]); w.y = cvt_pk_bf16(a[2], a[3]); w.z = cvt_pk_bf16(b[0], b[1]); w.w = cvt_pk_bf16(b[2], b[3]); return w; }
__device__ __forceinline__ f32x4 unlo(u32x4 w) { f32x4 r; r[0] = __uint_as_float(w.x << 16); r[1] = __uint_as_float(w.x & 0xffff0000u); r[2] = __uint_as_float(w.y << 16); r[3] = __uint_as_float(w.y & 0xffff0000u); return r; }
__device__ __forceinline__ f32x4 unhi(u32x4 w) { f32x4 r; r[0] = __uint_as_float(w.z << 16); r[1] = __uint_as_float(w.z & 0xffff0000u); r[2] = __uint_as_float(w.w << 16); r[3] = __uint_as_float(w.w & 0xffff0000u); return r; }
__device__ __forceinline__ unsigned pkh(float lo, float hi) { half2_t h; h.x = (_Float16)lo; h.y = (_Float16)hi; return __builtin_bit_cast(unsigned, h); }
__device__ __forceinline__ u32x4 pack8h(f32x4 a, f32x4 b) { u32x4 w; w.x = pkh(a[0], a[1]); w.y = pkh(a[2], a[3]); w.z = pkh(b[0], b[1]); w.w = pkh(b[2], b[3]); return w; }
__device__ __forceinline__ float h2f_lo(unsigned w) { return (float)__builtin_bit_cast(_Float16, (unsigned short)(w & 0xffffu)); }
__device__ __forceinline__ float h2f_hi(unsigned w) { return (float)__builtin_bit_cast(_Float16, (unsigned short)(w >> 16)); }
__device__ __forceinline__ f32x4 unlo_h(u32x4 w) { const unsigned a = w.x, b = w.y; f32x4 r; r[0] = h2f_lo(a); r[1] = h2f_hi(a); r[2] = h2f_lo(b); r[3] = h2f_hi(b); return r; }
__device__ __forceinline__ f32x4 unhi_h(u32x4 w) { const unsigned a = w.z, b = w.w; f32x4 r; r[0] = h2f_lo(a); r[1] = h2f_hi(a); r[2] = h2f_lo(b); r[3] = h2f_hi(b); return r; }
__device__ __forceinline__ f32x4 ex2v(f32x4 v) { f32x4 r; r[0] = ex2(v[0]); r[1] = ex2(v[1]); r[2] = ex2(v[2]); r[3] = ex2(v[3]); return r; }
__device__ __forceinline__ f32x4 sigv(f32x4 v) { f32x4 r; r[0] = sigm(v[0]); r[1] = sigm(v[1]); r[2] = sigm(v[2]); r[3] = sigm(v[3]); return r; }
__device__ __forceinline__ f32x4 geluv(f32x4 x) {
    f32x4 r;
#pragma unroll
    for (int i = 0; i < 4; ++i) { const float v = x[i], u = 0.7978845608028654f * (v + 0.044715f * v * v * v); r[i] = v * rcpf_(1.0f + ex2(-2.8853900817779268f * u)); }
    return r;
}

__device__ __forceinline__ void lru_step(float l, float q, float& H) { const float a = ex2(l); H = a * H + __builtin_amdgcn_sqrtf(fmaxf(1.0f - a * a, 0.f)) * q; }
__device__ __forceinline__ float sum16(const float* p) { const f32x4 a = *(const f32x4*)p, b = *(const f32x4*)(p + 4), c = *(const f32x4*)(p + 8), d = *(const f32x4*)(p + 12);
    const f32x4 s = (a + b) + (c + d); return (s[0] + s[1]) + (s[2] + s[3]); }
__device__ __forceinline__ float row_rs(const float* ssp, int row) { return rsq(sum16(ssp + (size_t)row * 16) * (1.0f / 1024.0f) + EPS); }
namespace pg8 {
constexpr int BM = 256, BK = 64, HALF = 128, HTB = HALF * BK * 2, STAGE_BYTES = 8 * HTB;
__device__ __forceinline__ int lds_byte(int r, int c) { const int st = (r >> 4) * 2 + (c >> 5), rr = r & 15, cc = c & 31, ob = rr * 64 + cc * 2; return st * 1024 + (ob ^ (((ob >> 9) & 1) << 5)); }
__device__ __forceinline__ void stage_rc(int b, int& R, int& C) { const int st = b / 1024, sb = b % 1024, swz = sb ^ (((sb >> 9) & 1) << 5); R = (st >> 1) * 16 + swz / 64; C = (st & 1) * 32 + (swz % 64) / 2; }
__device__ __forceinline__ int perm32(int rho) { const int n = rho >> 4, i = rho & 15; return 8 * (i >> 2) + 4 * n + (i & 3); }
struct Unit { const char *a0, *a1, *b0, *b1; int pm, pn, z; };

struct NoHook { static constexpr bool ON = false; };
struct HeadRescale { static constexpr bool ON = true; const float* rq; };
template <class Epi, class Sched, class Hook = NoHook>
__device__ __forceinline__ void gemm_phase(LAS unsigned char* lds, const int lda, const int ldb, const int K, const Sched& S, const Epi& E, const Hook HK = Hook()) {
    int tid = threadIdx.x; asm volatile("" : "+v"(tid));
    const int wid = __builtin_amdgcn_readfirstlane(tid >> 6), lane = tid & 63, wr = wid >> 2, wc = wid & 3, fr = lane & 15, fq = lane >> 4;
    const int nt = K / BK;
    unsigned voffA[2], voffB[2];
#pragma unroll
    for (int i = 0; i < 2; ++i) { int R, C; stage_rc(tid * 16 + i * 8192, R, C); const int Rb = (R & ~31) + perm32(R & 31);
        voffA[i] = (unsigned)(R * lda + C) * 2u; voffB[i] = (unsigned)(Rb * ldb + C) * 2u; }
    const size_t kstep = (size_t)(BK * 2);
    const unsigned ldsw = (unsigned)wid * 1024u;
    const int aoff = lds_byte(wr * 64 + fr, fq * 8), boff = lds_byte(wc * 32 + fr, fq * 8);
#define PG8_SA(b, h) (((b) * 2 + (h)) * HTB)
#define PG8_SB(b, h) ((4 + (b) * 2 + (h)) * HTB)
#define PG8_STAGE(bufoff, gbase, voff) do { _Pragma("unroll") for (int _i = 0; _i < 2; ++_i) \
        __builtin_amdgcn_global_load_lds((const unsigned*)((const char*)(gbase) + (voff)[_i]), (LAS unsigned*)(lds + (bufoff) + ldsw + _i * 8192), 16, 0, 0); } while (0)
#define PG8_LDA(dst, b, h) do { _Pragma("unroll") for (int m = 0; m < 4; ++m) _Pragma("unroll") for (int k = 0; k < 2; ++k) dst[m][k] = *(const LAS bf16x8*)(lds + PG8_SA(b, h) + aoff + m * 2048 + k * 1024); } while (0)
#define PG8_LDB(dst, b, h) do { _Pragma("unroll") for (int n = 0; n < 2; ++n) _Pragma("unroll") for (int k = 0; k < 2; ++k) dst[n][k] = *(const LAS bf16x8*)(lds + PG8_SB(b, h) + boff + n * 2048 + k * 1024); } while (0)
#define PG8_MMA(ai, bj, At, Bt) do { __builtin_amdgcn_s_setprio(1); _Pragma("unroll") for (int m = 0; m < 4; ++m) _Pragma("unroll") for (int n = 0; n < 2; ++n) _Pragma("unroll") for (int k = 0; k < 2; ++k) \
        acc[ai][bj][m][n] = __builtin_amdgcn_mfma_f32_16x16x32_bf16(Bt[n][k], At[m][k], acc[ai][bj][m][n], 0, 0, 0); __builtin_amdgcn_s_setprio(0); } while (0)
#define PG8_WAIT_V(n) asm volatile("s_waitcnt vmcnt(" #n ")" ::: "memory")
#define PG8_WAIT_L(n) asm volatile("s_waitcnt lgkmcnt(" #n ")" ::: "memory")
#define PG8_BAR __builtin_amdgcn_s_barrier()
#define PG8_SCHED __builtin_amdgcn_sched_barrier(0)
    Unit cur, nxt; int ui = 0;
    if (!S.next(0, cur)) return;
#define PG8_OPAQUE(u) asm volatile("" : "+s"((u).a0), "+s"((u).a1), "+s"((u).b0), "+s"((u).b1))
    PG8_OPAQUE(cur);
    f32x4 acc[2][2][4][2];
#pragma unroll
    for (int a = 0; a < 2; ++a)
#pragma unroll
        for (int b = 0; b < 2; ++b)
#pragma unroll
            for (int m = 0; m < 4; ++m)
#pragma unroll
                for (int n = 0; n < 2; ++n) acc[a][b][m][n] = (f32x4){0.f, 0.f, 0.f, 0.f};
    bf16x8 At[4][2], B0[2][2], B1[2][2];
    float hkr[8] = {1.f, 1.f, 1.f, 1.f, 1.f, 1.f, 1.f, 1.f}; (void)hkr;
    const char *cA0 = cur.a0, *cA1 = cur.a1, *cB0 = cur.b0, *cB1 = cur.b1;
    PG8_STAGE(PG8_SB(0, 0), cB0, voffB); PG8_STAGE(PG8_SB(0, 1), cB1, voffB); PG8_STAGE(PG8_SA(0, 0), cA0, voffA); PG8_STAGE(PG8_SA(0, 1), cA1, voffA);
    if (wr == 1) PG8_BAR;
    PG8_WAIT_V(2); PG8_BAR;
    PG8_STAGE(PG8_SB(1, 0), cB0 + kstep, voffB); PG8_STAGE(PG8_SA(1, 0), cA0 + kstep, voffA); PG8_STAGE(PG8_SB(1, 1), cB1 + kstep, voffB);
    PG8_WAIT_V(6); PG8_BAR;
    for (;;) {
        const bool has_next = S.next(ui + 1, nxt);
        if (has_next) PG8_OPAQUE(nxt);
        const char *nA0 = has_next ? nxt.a0 : cA0, *nA1 = has_next ? nxt.a1 : cA1, *nB0 = has_next ? nxt.b0 : cB0, *nB1 = has_next ? nxt.b1 : cB1;
#pragma unroll 1
        for (int t = 0; t < nt; t += 2) {
            const bool last = (t == nt - 2);
            bool hk = false;
            if constexpr (Hook::ON) { hk = (((t + 2) & 7) == 0) && (t + 2 < nt);
                if (hk) { const int hd = ((t + 2) >> 3) - 1;
                    int frh = fr; asm volatile("" : "+v"(frh));
#pragma unroll
                    for (int ai = 0; ai < 2; ++ai)
#pragma unroll
                        for (int m = 0; m < 4; ++m) hkr[ai * 4 + m] = HK.rq[(size_t)(cur.pm * 256 + ai * 128 + wr * 64 + m * 16 + frh) * 4 + hd]; } }
            const char* a1_1 = cA1 + (size_t)(t + 1) * kstep;
            const char* a2_0 = last ? nA0 : cA0 + (size_t)(t + 2) * kstep; const char* a2_1 = last ? nA1 : cA1 + (size_t)(t + 2) * kstep;
            const char* b2_0 = last ? nB0 : cB0 + (size_t)(t + 2) * kstep; const char* b2_1 = last ? nB1 : cB1 + (size_t)(t + 2) * kstep;
            const char* a3_0 = a2_0 + kstep; const char* b3_0 = b2_0 + kstep; const char* b3_1 = b2_1 + kstep;
            PG8_LDB(B0, 0, 0); PG8_LDB(B1, 0, 1); PG8_SCHED; PG8_LDA(At, 0, 0); PG8_STAGE(PG8_SA(1, 1), a1_1, voffA);
            PG8_WAIT_V(8); PG8_WAIT_L(0); PG8_BAR; PG8_MMA(0, 0, At, B0); PG8_MMA(0, 1, At, B1); PG8_BAR; PG8_SCHED;
            PG8_LDA(At, 0, 1); PG8_STAGE(PG8_SB(0, 0), b2_0, voffB); PG8_STAGE(PG8_SB(0, 1), b2_1, voffB); PG8_STAGE(PG8_SA(0, 0), a2_0, voffA);
            PG8_WAIT_V(8); PG8_WAIT_L(0); PG8_BAR; PG8_MMA(1, 0, At, B0); PG8_MMA(1, 1, At, B1); PG8_BAR; PG8_SCHED;
            PG8_LDB(B0, 1, 0); PG8_LDB(B1, 1, 1); PG8_SCHED; PG8_LDA(At, 1, 0); PG8_STAGE(PG8_SA(0, 1), a2_1, voffA);
            PG8_WAIT_V(8); PG8_WAIT_L(0); PG8_BAR; PG8_MMA(0, 0, At, B0); PG8_MMA(0, 1, At, B1); PG8_BAR; PG8_SCHED;
            PG8_LDA(At, 1, 1); PG8_STAGE(PG8_SB(1, 0), b3_0, voffB); PG8_STAGE(PG8_SB(1, 1), b3_1, voffB); PG8_STAGE(PG8_SA(1, 0), a3_0, voffA);
            PG8_WAIT_V(8); PG8_WAIT_L(0); PG8_BAR; PG8_MMA(1, 0, At, B0); PG8_MMA(1, 1, At, B1); PG8_BAR; PG8_SCHED;
            if constexpr (Hook::ON) { if (hk) {
#pragma unroll
                for (int ai = 0; ai < 2; ++ai)
#pragma unroll
                    for (int bj = 0; bj < 2; ++bj)
#pragma unroll
                        for (int m = 0; m < 4; ++m)
#pragma unroll
                            for (int n = 0; n < 2; ++n) acc[ai][bj][m][n] = acc[ai][bj][m][n] * hkr[ai * 4 + m]; } }
        }
        if (wr == 0) PG8_BAR;
        { int fr_ = fr, fq_ = fq; asm volatile("" : "+v"(fr_), "+v"(fq_)); E(acc, cur, wr, wc, fr_, fq_); }
        if (!has_next) break;
#pragma unroll
        for (int a = 0; a < 2; ++a)
#pragma unroll
            for (int b = 0; b < 2; ++b)
#pragma unroll
                for (int m = 0; m < 4; ++m)
#pragma unroll
                    for (int n = 0; n < 2; ++n) acc[a][b][m][n] = (f32x4){0.f, 0.f, 0.f, 0.f};
        cur = nxt; cA0 = nA0; cA1 = nA1; cB0 = nB0; cB1 = nB1; ++ui;
        if (wr == 1) PG8_BAR;
    }
    PG8_WAIT_V(0);
    PG8_BAR;
#undef PG8_OPAQUE
#undef PG8_SA
#undef PG8_SB
#undef PG8_STAGE
#undef PG8_LDA
#undef PG8_LDB
#undef PG8_MMA
#undef PG8_WAIT_V
#undef PG8_WAIT_L
#undef PG8_BAR
#undef PG8_SCHED
}
}
using pg8::Unit;
typedef const f32x4 (&AccRef)[2][2][4][2];

__device__ __forceinline__ bool order2d(int i, int G, int c, int nM, int nN, int& pm, int& pn) {
    const int nwg = nM * nN; const long L = (long)i * G + c; if (L >= nwg) return false;
    int wgid = (int)L; { const int q = nwg / 8, r = nwg % 8, xcd = wgid % 8, off = wgid / 8; wgid = (xcd < r ? xcd * (q + 1) : r * (q + 1) + (xcd - r) * q) + off; }
    const int nig = 8 * nN, gid = wgid / nig, fm = gid * 8, gsz = (nM - fm) < 8 ? (nM - fm) : 8;
    pm = fm + ((wgid % nig) % gsz); pn = (wgid % nig) / gsz; return true;
}
struct StdSched {
    const char *A, *B; int nM, nN, lda, ldb, G, c;
    __device__ __forceinline__ bool next(int i, Unit& u) const {
        int pm, pn; if (!order2d(i, G, c, nM, nN, pm, pn)) return false;
        u.pm = pm; u.pn = pn; u.z = 0; u.a0 = A + (size_t)pm * 256 * lda * 2; u.a1 = u.a0 + (size_t)128 * lda * 2; u.b0 = B + (size_t)pn * 256 * ldb * 2; u.b1 = u.b0 + (size_t)128 * ldb * 2; return true; }
};
struct GateSched {
    const char *XB, *WGA, *WGX; int G, c;
    __device__ __forceinline__ bool next(int i, Unit& u) const {
        int pm, pn; if (!order2d(i, G, c, 128, 16, pm, pn)) return false;
        const int z = pn >> 2, d = (pn >> 1) & 1, hf = pn & 1; u.pm = pm; u.pn = pn; u.z = 0;
        u.a0 = XB + ((size_t)pm * 256 * 1024 + z * 256) * 2; u.a1 = u.a0 + (size_t)128 * 1024 * 2;
        const size_t bo = (size_t)(((d * 4 + z) * 256 + hf * 128) * 256) * 2; u.b0 = WGA + bo; u.b1 = WGX + bo; return true; }
};
struct FfnUpSched {
    const char *A, *WG, *WU; int G, c;
    __device__ __forceinline__ bool next(int i, Unit& u) const {
        int pm, pn; if (!order2d(i, G, c, 128, 22, pm, pn)) return false;
        u.pm = pm; u.pn = pn; u.z = 0; u.a0 = A + (size_t)pm * 256 * 1024 * 2; u.a1 = u.a0 + (size_t)128 * 1024 * 2;
        u.b0 = WG + (size_t)pn * 128 * 1024 * 2; u.b1 = WU + (size_t)pn * 128 * 1024 * 2; return true; }
};
struct ScoreSched {
    const char *A2, *KB; int G, c;
    __device__ __forceinline__ bool next(int i, Unit& u) const {
        const int L = i * G + c; if (L >= 128) return false;
        const int z = L, bl = z >> 6, h = (z >> 4) & 3, cc = z & 15; u.pm = 0; u.pn = 0; u.z = z;
        u.a0 = A2 + ((size_t)z * 256 * 768 + 256) * 2; u.a1 = u.a0 + (size_t)128 * 768 * 2;
        u.b0 = KB + (((size_t)bl * 4096 + cc * 256) * 1024 + h * 256) * 2; u.b1 = u.b0 + (size_t)128 * 1024 * 2; return true; }
};
struct KvSched {
    const char *BT2, *KTF, *KTB; int G, c;
    __device__ __forceinline__ bool next(int i, Unit& u) const {
        const int L = i * G + c; if (L >= 512) return false;
        const int xq = L & 7, sq_ = L >> 3;
        const int z = xq * 16 + (sq_ >> 2), dir = (sq_ >> 1) & 1, dvh = sq_ & 1, bl = z >> 6, h = (z >> 4) & 3, cc = z & 15; u.pm = dvh; u.pn = dir; u.z = z;
        u.a0 = BT2 + ((size_t)(z * 512 + dvh * 256) * 768) * 2; u.a1 = u.a0 + (size_t)128 * 768 * 2;
        u.b0 = (dir ? KTB : KTF) + ((size_t)(h * 256) * TG + bl * 4096 + cc * 256) * 2; u.b1 = u.b0 + (size_t)128 * TG * 2; return true; }
};
struct YSched {
    const char *A2, *BT2; int G, c;
    __device__ __forceinline__ bool next(int i, Unit& u) const {
        const int L = i * G + c; if (L >= 256) return false;
        const int xq = L & 7, sq_ = L >> 3; const int z = xq * 16 + (sq_ >> 1), dvh = sq_ & 1; u.pm = 0; u.pn = dvh; u.z = z;
        u.a0 = A2 + (size_t)z * 256 * 768 * 2; u.a1 = u.a0 + (size_t)128 * 768 * 2;
        u.b0 = BT2 + ((size_t)(z * 512 + dvh * 256) * 768) * 2; u.b1 = u.b0 + (size_t)128 * 768 * 2; return true; }
};

__device__ __forceinline__ void rows_rs8(const float* ssp, int row0, int fq, float (&rsv)[8]) {
    f32x4 p[8];
#pragma unroll
    for (int i = 0; i < 8; ++i) p[i] = *(const f32x4*)(ssp + (size_t)(row0 + (i >> 2) * 128 + (i & 3) * 16) * 16 + fq * 4);
#pragma unroll
    for (int i = 0; i < 8; ++i) { float s_ = (p[i][0] + p[i][1]) + (p[i][2] + p[i][3]); s_ += __shfl_xor(s_, 16); s_ += __shfl_xor(s_, 32); rsv[i] = rsq(s_ * (1.0f / 1024.0f) + EPS); }
}
__device__ __forceinline__ void rows_rs4(const float* ssp, int row0, int fq, float (&rsv)[4]) {
    f32x4 p[4];
#pragma unroll
    for (int i = 0; i < 4; ++i) p[i] = *(const f32x4*)(ssp + (size_t)(row0 + i * 16) * 16 + fq * 4);
#pragma unroll
    for (int i = 0; i < 4; ++i) { float s_ = (p[i][0] + p[i][1]) + (p[i][2] + p[i][3]); s_ += __shfl_xor(s_, 16); s_ += __shfl_xor(s_, 32); rsv[i] = rsq(s_ * (1.0f / 1024.0f) + EPS); }
}
#ifndef ST_SC1
#define ST_SC1 0
#endif
#if ST_SC1
#define ST16(p, v) do { const u32x4 v_ = (v); const void* p_ = (const void*)(p); asm volatile("global_store_dwordx4 %0, %1, off sc1" :: "v"(p_), "v"(v_) : "memory"); } while (0)
#else
#define ST16(p, v) do { *(u32x4*)(p) = (v); } while (0)
#endif
#define EPI_ARGS AccRef acc, const Unit& u, int wr, int wc, int fr, int fq
__device__ __forceinline__ bool epi_fence() { asm volatile("" ::: "memory"); __builtin_amdgcn_sched_barrier(0); return true; }
#define FOR_AI_M _Pragma("unroll") for (int ai = 0; ai < 2; ++ai) _Pragma("unroll") for (int m = 0; m < 4; ++m) if (epi_fence())

struct EpiP1 {
    bf16_t* xbp; bf16_t* gg;
    __device__ __forceinline__ void operator()(EPI_ARGS) const {
        const int row0 = u.pm * 256 + wr * 64 + fr;
        if (u.pn < 4) {
            FOR_AI_M { bf16_t* rp = xbp + (size_t)(row0 + ai * 128 + m * 16) * 1024 + u.pn * 256 + wc * 32 + fq * 8;
#pragma unroll
                for (int bj = 0; bj < 2; ++bj) ST16((rp + bj * 128), pack8(acc[ai][bj][m][0], acc[ai][bj][m][1])); }
        } else {
            const int b = u.pm >> 4;
            FOR_AI_M { const int t = (row0 + ai * 128 + m * 16) & 4095;
#pragma unroll
                for (int bj = 0; bj < 2; ++bj) { const int cgp = (u.pn - 4) * 8 + bj * 4 + wc;
                    bf16_t* p = gg + ((size_t)((b * 32 + cgp) * 4096 + t)) * 32 + fq * 8;
                    ST16(p, pack8(geluv(acc[ai][bj][m][0]), geluv(acc[ai][bj][m][1]))); } }
        }
    }
};
struct EpiGate {
    const bf16_t* xb; const float *ga_b, *gx_b, *cla; unsigned short* laf; bf16_t* inf; unsigned short* lab; bf16_t* inb;
    __device__ __forceinline__ void operator()(EPI_ARGS) const {
        const int z = u.pn >> 2, d = (u.pn >> 1) & 1, hf = u.pn & 1;
        const int ch0 = z * 256 + hf * 128 + wc * 32 + fq * 8;
        const f32x4 ba0 = *(const f32x4*)(ga_b + d * 1024 + ch0), ba1 = *(const f32x4*)(ga_b + d * 1024 + ch0 + 4);
        const f32x4 bx0 = *(const f32x4*)(gx_b + d * 1024 + ch0), bx1 = *(const f32x4*)(gx_b + d * 1024 + ch0 + 4);
        const f32x4 cl0 = *(const f32x4*)(cla + d * 1024 + ch0), cl1 = *(const f32x4*)(cla + d * 1024 + ch0 + 4);
        const int b = u.pm >> 4, cgp = z * 8 + hf * 4 + wc;
        unsigned short* lap = d ? lab : laf; bf16_t* inp = d ? inb : inf;
        u32x4 xw8[8];
#pragma unroll
        for (int i = 0; i < 8; ++i) xw8[i] = *(const u32x4*)(xb + (size_t)(u.pm * 256 + (i >> 2) * 128 + wr * 64 + (i & 3) * 16 + fr) * 1024 + ch0);
        FOR_AI_M { const int row = u.pm * 256 + ai * 128 + wr * 64 + m * 16 + fr, t = row & 4095;
            const u32x4 xw = xw8[ai * 4 + m];
            const f32x4 x0 = unlo(xw), x1 = unhi(xw);
            const f32x4 r0 = sigv(acc[ai][0][m][0] + ba0), r1 = sigv(acc[ai][0][m][1] + ba1);
            const f32x4 i0 = sigv(acc[ai][1][m][0] + bx0), i1 = sigv(acc[ai][1][m][1] + bx1);
            const f32x4 l0 = r0 * cl0, l1 = r1 * cl1;
            const f32x4 q0 = i0 * x0, q1 = i1 * x1;
            const size_t off = ((size_t)((b * 32 + cgp) * 4096 + t)) * 32 + fq * 8;
            ST16((lap + off), pack8h(l0, l1));
            ST16((inp + off), pack8(q0, q1)); }
    }
};
template <bool BASE_F32, bool SCALED = false> struct EpiRes {
    const float* basef; bf16_t* xn; float* ss; const float* rq;
    __device__ __forceinline__ void operator()(EPI_ARGS) const {
        constexpr bool PIPE = BASE_F32 || SCALED;
        u32x4 bw16[16]; f32x4 fb[2][4]; u32x4 bb[2][2]; float scb[2] = {1.f, 1.f};
        const size_t off00 = (size_t)(u.pm * 256 + wr * 64 + fr) * 1024 + u.pn * 256 + wc * 32 + fq * 8;
        if constexpr (!PIPE) {
#pragma unroll
            for (int i = 0; i < 16; ++i) bw16[i] = *(const u32x4*)(xn + off00 + (size_t)((i >> 3) * 128 + ((i >> 1) & 3) * 16) * 1024 + (i & 1) * 128);
        } else if constexpr (BASE_F32) {
#pragma unroll
            for (int q = 0; q < 4; ++q) fb[0][q] = *(const f32x4*)(basef + off00 + (q >> 1) * 128 + (q & 1) * 4);
        } else {
            bb[0][0] = *(const u32x4*)(xn + off00); bb[0][1] = *(const u32x4*)(xn + off00 + 128); scb[0] = rq[(size_t)(u.pm * 256 + wr * 64 + fr) * 4 + 3];
        }
        FOR_AI_M { const int row = u.pm * 256 + ai * 128 + wr * 64 + m * 16 + fr; float sq = 0.f; const int k = ai * 4 + m;
            if constexpr (PIPE) { if (k < 7) { const int k1 = k + 1; const size_t o1 = off00 + (size_t)((k1 >> 2) * 128 + (k1 & 3) * 16) * 1024;
                if constexpr (BASE_F32) {
#pragma unroll
                    for (int q = 0; q < 4; ++q) fb[k1 & 1][q] = *(const f32x4*)(basef + o1 + (q >> 1) * 128 + (q & 1) * 4);
                } else { bb[k1 & 1][0] = *(const u32x4*)(xn + o1); bb[k1 & 1][1] = *(const u32x4*)(xn + o1 + 128);
                    scb[k1 & 1] = rq[(size_t)(u.pm * 256 + (k1 >> 2) * 128 + wr * 64 + (k1 & 3) * 16 + fr) * 4 + 3]; } } }
            const float sc = SCALED ? scb[k & 1] : 1.0f;
#pragma unroll
            for (int bj = 0; bj < 2; ++bj) { const size_t off = (size_t)row * 1024 + u.pn * 256 + bj * 128 + wc * 32 + fq * 8;
                f32x4 h0, h1;
                if constexpr (BASE_F32) { h0 = fb[k & 1][bj * 2] + acc[ai][bj][m][0]; h1 = fb[k & 1][bj * 2 + 1] + acc[ai][bj][m][1]; }
                else { const u32x4 bw = SCALED ? bb[k & 1][bj] : bw16[k * 2 + bj]; h0 = unlo(bw) + acc[ai][bj][m][0] * sc; h1 = unhi(bw) + acc[ai][bj][m][1] * sc; }
                ST16((xn + off), pack8(h0, h1));
                sq += (h0[0] * h0[0] + h0[1] * h0[1]) + (h0[2] * h0[2] + h0[3] * h0[3]) + (h1[0] * h1[0] + h1[1] * h1[1]) + (h1[2] * h1[2] + h1[3] * h1[3]); }
            sq += __shfl_xor(sq, 16); sq += __shfl_xor(sq, 32);
            if (fq == 0) ss[(size_t)row * 16 + u.pn * 4 + wc] = sq; }
    }
};
struct EpiFfnUp {
    const float* ss; bf16_t* act;
    __device__ __forceinline__ void operator()(EPI_ARGS) const {
        float rsv[8]; rows_rs8(ss, u.pm * 256 + wr * 64 + fr, fq, rsv);
        FOR_AI_M { const int row = u.pm * 256 + ai * 128 + wr * 64 + m * 16 + fr; const float rs = rsv[ai * 4 + m];
            const f32x4 g0 = acc[ai][0][m][0] * rs, g1 = acc[ai][0][m][1] * rs, u0 = acc[ai][1][m][0] * rs, u1 = acc[ai][1][m][1] * rs;
            ST16((act + (size_t)row * FF + u.pn * 128 + wc * 32 + fq * 8), pack8(g0 * sigv(g0) * u0, g1 * sigv(g1) * u1)); }
    }
};
struct EpiRetA {
    const float* ss; const float *cost, *sint; bf16_t *a2, *sg, *kb; int g;
    __device__ __forceinline__ void operator()(EPI_ARGS) const {
        const int bl = u.pm >> 4, cc = u.pm & 15;
        if (u.pn >= 4 && u.pn < 12) {
#pragma unroll
            for (int ai = 0; ai < 2; ++ai) { float rs4[4]; rows_rs4(ss, g * TG + u.pm * 256 + ai * 128 + wr * 64 + fr, fq, rs4);
#pragma unroll
                for (int m = 0; m < 4; ++m) if (epi_fence()) { const int r = ai * 128 + wr * 64 + m * 16 + fr, rowg = u.pm * 256 + r; const float rs = rs4[m];
#pragma unroll
                    for (int bj = 0; bj < 2; ++bj) { const f32x4 v0 = acc[ai][bj][m][0] * rs, v1 = acc[ai][bj][m][1] * rs;
                        ST16((sg + (size_t)rowg * 2048 + (u.pn - 4) * 256 + bj * 128 + wc * 32 + fq * 8), pack8(v0 * sigv(v0), v1 * sigv(v1))); } } }
        } else {
            const bool isq = u.pn < 4; const int h = isq ? u.pn : u.pn - 12; const int j0 = wc * 32 + fq * 8;
            const float lf = l2gam(h), lb = l2gam(3 - h);
#pragma unroll
            for (int ai = 0; ai < 2; ++ai) { float rs4[4]; rows_rs4(ss, g * TG + u.pm * 256 + ai * 128 + wr * 64 + fr, fq, rs4);
                f32x4 tb[2][4];
                { const int pos = (u.pm * 256 + ai * 128 + wr * 64 + fr) & 4095; tb[0][0] = *(const f32x4*)(cost + pos * 128 + j0); tb[0][1] = *(const f32x4*)(cost + pos * 128 + j0 + 4);
                  tb[0][2] = *(const f32x4*)(sint + pos * 128 + j0); tb[0][3] = *(const f32x4*)(sint + pos * 128 + j0 + 4); }
#pragma unroll
                for (int m = 0; m < 4; ++m) if (epi_fence()) { const int r = ai * 128 + wr * 64 + m * 16 + fr, rowg = u.pm * 256 + r; const float rs = rs4[m];
                    if (m < 3) { const int pn_ = (rowg + 16) & 4095; tb[(m + 1) & 1][0] = *(const f32x4*)(cost + pn_ * 128 + j0); tb[(m + 1) & 1][1] = *(const f32x4*)(cost + pn_ * 128 + j0 + 4);
                        tb[(m + 1) & 1][2] = *(const f32x4*)(sint + pn_ * 128 + j0); tb[(m + 1) & 1][3] = *(const f32x4*)(sint + pn_ * 128 + j0 + 4); }
                    const f32x4 c0 = tb[m & 1][0], c1 = tb[m & 1][1], s0 = tb[m & 1][2], s1 = tb[m & 1][3];
                    const f32x4 x10 = acc[ai][0][m][0] * rs, x11 = acc[ai][0][m][1] * rs, x20 = acc[ai][1][m][0] * rs, x21 = acc[ai][1][m][1] * rs;
                    const f32x4 o10 = x10 * c0 - x20 * s0, o11 = x11 * c1 - x21 * s1, o20 = x20 * c0 + x10 * s0, o21 = x21 * c1 + x11 * s1;
                    if (isq) {
                        const float wf = ex2(lf * (float)(r + 1)), wb = ex2(lb * (float)(256 - r));
                        bf16_t* p = a2 + ((size_t)(((bl * 4 + h) * 16 + cc) * 256 + r)) * 768 + 256 + j0;
                        ST16((p), pack8(o10 * wf, o11 * wf)); ST16((p + 128), pack8(o20 * wf, o21 * wf));
                        ST16((p + 256), pack8(o10 * wb, o11 * wb)); ST16((p + 384), pack8(o20 * wb, o21 * wb));
                    } else {
                        bf16_t* p = kb + (size_t)rowg * 1024 + h * 256 + j0;
                        ST16((p), pack8(o10 * 0.0625f, o11 * 0.0625f)); ST16((p + 128), pack8(o20 * 0.0625f, o21 * 0.0625f));
                    } } }
        }
    }
};
struct EpiRetB {
    const float* ss; bf16_t* bt2; int g;
    __device__ __forceinline__ void operator()(EPI_ARGS) const {
        const int bl = u.pn >> 4, cc = u.pn & 15;
#pragma unroll
        for (int bj = 0; bj < 2; ++bj) {
            const int jt0 = bj * 128 + wc * 32 + fq * 8, tl0 = u.pn * 256 + jt0;
            f32x4 rs0, rs1;
#pragma unroll
            for (int e = 0; e < 4; ++e) { rs0[e] = row_rs(ss, g * TG + tl0 + e); rs1[e] = row_rs(ss, g * TG + tl0 + 4 + e); }
            FOR_AI_M { const int vrow = u.pm * 256 + ai * 128 + wr * 64 + m * 16 + fr, h = vrow >> 9, dv = vrow & 511;
                ST16((bt2 + ((size_t)(((bl * 4 + h) * 16 + cc) * 512 + dv)) * 768 + jt0), pack8(acc[ai][bj][m][0] * rs0, acc[ai][bj][m][1] * rs1)); }
        }
    }
};
struct EpiScore {
    bf16_t* a2;
    __device__ __forceinline__ void operator()(EPI_ARGS) const {
        const int h = (u.z >> 4) & 3; const float lf = l2gam(h), lb = l2gam(3 - h);
        FOR_AI_M { const int jn = ai * 128 + wr * 64 + m * 16 + fr;
#pragma unroll
            for (int bj = 0; bj < 2; ++bj) { const int jm0 = bj * 128 + wc * 32 + fq * 8; f32x4 p0, p1;
#pragma unroll
                for (int e = 0; e < 4; ++e) { const int ja = jm0 + e, jb = jm0 + 4 + e;
                    const float ea = -lf * (float)(min(ja, jn) + 1) + lb * (float)max(ja - jn, 0);
                    const float eb = -lf * (float)(min(jb, jn) + 1) + lb * (float)max(jb - jn, 0);
                    p0[e] = acc[ai][bj][m][0][e] * ex2(ea); p1[e] = acc[ai][bj][m][1][e] * ex2(eb); }
                ST16((a2 + ((size_t)(u.z * 256 + jn)) * 768 + jm0), pack8(p0, p1)); } }
    }
};
struct EpiKv {
    bf16_t* bt2;
    __device__ __forceinline__ void operator()(EPI_ARGS) const {
        FOR_AI_M { const int r = ai * 128 + wr * 64 + m * 16 + fr;
            bf16_t* p = bt2 + ((size_t)(u.z * 512 + u.pm * 256 + r)) * 768 + 256 + u.pn * 256 + wc * 32 + fq * 8;
#pragma unroll
            for (int bj = 0; bj < 2; ++bj) ST16((p + bj * 128), pack8(acc[ai][bj][m][0], acc[ai][bj][m][1])); }
    }
};
struct EpiY {
    bf16_t* yz; float* yss; const bf16_t* sg; int g;
    __device__ __forceinline__ void operator()(EPI_ARGS) const {
        const int bl = u.z >> 6, h = (u.z >> 4) & 3, cc = u.z & 15;
#pragma unroll
        for (int ai = 0; ai < 2; ++ai) { u32x4 gw8[8];
#pragma unroll
          for (int i = 0; i < 8; ++i) gw8[i] = *(const u32x4*)(sg + (size_t)(bl * 4096 + cc * 256 + ai * 128 + wr * 64 + (i >> 1) * 16 + fr) * 2048 + h * 512 + u.pn * 256 + wc * 32 + fq * 8 + (i & 1) * 128);
#pragma unroll
          for (int m = 0; m < 4; ++m) if (epi_fence()) { const int r = ai * 128 + wr * 64 + m * 16 + fr, tok = g * TG + bl * 4096 + cc * 256 + r; float sq = 0.f;
            bf16_t* p = yz + (size_t)tok * 2048 + h * 512 + u.pn * 256 + wc * 32 + fq * 8;
#pragma unroll
            for (int bj = 0; bj < 2; ++bj) { const f32x4 v0 = acc[ai][bj][m][0], v1 = acc[ai][bj][m][1];
                const u32x4 gw_ = gw8[m * 2 + bj];
                ST16((p + bj * 128), pack8(v0 * unlo(gw_), v1 * unhi(gw_)));
                sq += (v0[0] * v0[0] + v0[1] * v0[1]) + (v0[2] * v0[2] + v0[3] * v0[3]) + (v1[0] * v1[0] + v1[1] * v1[1]) + (v1[2] * v1[2] + v1[3] * v1[3]); }
            sq += __shfl_xor(sq, 16); sq += __shfl_xor(sq, 32);
            if (fq == 0) yss[(size_t)(tok * 4 + h) * 8 + u.pn * 4 + wc] = sq; } }
    }
};

__device__ __forceinline__ float wave_sum(float v) {
#pragma unroll
    for (int o = 1; o < 64; o <<= 1) v += __shfl_xor(v, o);
    return v;
}
__device__ __forceinline__ void tr_load(const float* W, int ldw, int nblk, int item, int lane, f32x4 (&v)[8]) {
    const int kb = item / nblk, nb = item % nblk, k0 = 64 * kb, n0 = 32 * nb, n4 = (lane & 7) * 4;
#pragma unroll
    for (int i = 0; i < 8; ++i) v[i] = *(const f32x4*)(W + (size_t)(k0 + i * 8 + (lane >> 3)) * ldw + n0 + n4);
}
__device__ __forceinline__ void tr_finish(const f32x4 (&v)[8], int K, int nblk, bf16_t* WT, LAS float* scr, int item, int lane, const float* gain) {
    const int kb = item / nblk, nb = item % nblk, k0 = 64 * kb, n0 = 32 * nb, n4 = (lane & 7) * 4;
#pragma unroll
    for (int i = 0; i < 8; ++i) { const int kk = i * 8 + (lane >> 3); const float gv = gain ? gain[k0 + kk] : 1.0f;
#pragma unroll
        for (int e = 0; e < 4; ++e) scr[kk * 33 + n4 + e] = v[i][e] * gv; }
    asm volatile("s_waitcnt lgkmcnt(0)" ::: "memory");
    const int c = lane & 7;
#pragma unroll
    for (int j = 0; j < 4; ++j) { const int n = (lane >> 3) + 8 * j; const LAS float* s = scr + (8 * c) * 33 + n;
        u32x4 o; o.x = cvt_pk_bf16(s[0 * 33], s[1 * 33]); o.y = cvt_pk_bf16(s[2 * 33], s[3 * 33]); o.z = cvt_pk_bf16(s[4 * 33], s[5 * 33]); o.w = cvt_pk_bf16(s[6 * 33], s[7 * 33]);
        ST16((WT + (size_t)(n0 + n) * K + k0 + 8 * c), o); }
    asm volatile("s_waitcnt lgkmcnt(0)" ::: "memory");
}
__device__ __forceinline__ void tr_item(const float* W, int ldw, int K, int nblk, bf16_t* WT, LAS float* scr, int item, int lane, const float* gain) {
    f32x4 v[8]; tr_load(W, ldw, nblk, item, lane, v); tr_finish(v, K, nblk, WT, scr, item, lane, gain);
}
__device__ __forceinline__ void tr_job(const float* W, int ldw, int K, int N, bf16_t* WT, const float* gain, LAS float* scr, int gw, int NGW, int lane) {
    const int nblk = N / 32, nitems = (K / 64) * nblk;
    for (int it = gw; it < nitems; it += NGW) tr_item(W, ldw, K, nblk, WT, scr, it, lane, gain);
}


#define SS1 ((float*)(ws + WS_SS1))
#define SS2 ((float*)(ws + WS_SS2))
#define SS3 ((float*)(ws + WS_SS3))
#define SS4 ((float*)(ws + WS_SS4))
#define YSS ((float*)(ws + WS_YSS))
#define COST ((float*)(ws + WS_COST))
#define SINT ((float*)(ws + WS_SINT))
#define COSJ ((float*)(ws + WS_COSJ))
#define SINJ ((float*)(ws + WS_SINJ))
#define CLA ((float*)(ws + WS_CLA))
#define WIN ((bf16_t*)(ws + WS_WIN))
#define WGA ((bf16_t*)(ws + WS_WGA))
#define WGX ((bf16_t*)(ws + WS_WGX))
#define WLO ((bf16_t*)(ws + WS_WLO))
#define WFG ((bf16_t*)(ws + WS_WFG))
#define WFU ((bf16_t*)(ws + WS_WFU))
#define WFD ((bf16_t*)(ws + WS_WFD))
#define WRI ((bf16_t*)(ws + WS_WRI))
#define WRO ((bf16_t*)(ws + WS_WRO))
#define XN ((bf16_t*)(ws + WS_XN))
#define XBP ((bf16_t*)(ws + WS_XBP))
#define GG ((bf16_t*)(ws + WS_GG))
#define XB ((bf16_t*)(ws + WS_XB))
#define YL ((bf16_t*)(ws + WS_YL))
#define ACT ((bf16_t*)(ws + WS_ACT))
#define YZ ((bf16_t*)(ws + WS_YZ))
#define A2 ((bf16_t*)(ws + WS_A2))
#define KB ((bf16_t*)(ws + WS_KB))
#define KTF ((bf16_t*)(ws + WS_KTF))
#define KTB ((bf16_t*)(ws + WS_KTB))
#define BT2 ((bf16_t*)(ws + WS_BT2))
#define SG ((bf16_t*)(ws + WS_SG))
#define INF ((bf16_t*)(ws + WS_INF))
#define INB ((bf16_t*)(ws + WS_INB))
#define LAF ((unsigned short*)(ws + WS_LAF))
#define LAB ((unsigned short*)(ws + WS_LAB))

#ifndef PHMASK
#define PHMASK 0xFFFFFFFFu
#endif
#define PHX(k) ((PHMASK >> (k)) & 1u)
#ifndef REPMASK
#define REPMASK 0u
#endif
#define NREP(k) (1 + (int)((REPMASK >> (k)) & 1u))
#ifndef SUBMASK
#define SUBMASK 3u
#endif

#ifdef DBG
constexpr size_t WS_DBG = 9 * MiB + 65536, WS_DBGBUF = 9 * MiB + 131072;
__device__ __forceinline__ float bfv(const bf16_t* p, size_t i) { return __uint_as_float((unsigned)p[i] << 16); }
__device__ __forceinline__ float hfv(const unsigned short* p, size_t i) { unsigned short v = p[i]; _Float16 h = __builtin_bit_cast(_Float16, v); return (float)h; }
__device__ __forceinline__ bool close_(float got, float ref, float rtol, float atol) { return fabsf(got - ref) <= atol + rtol * fabsf(ref); }
__device__ __forceinline__ unsigned hsh(unsigned x) { x ^= x >> 16; x *= 0x7feb352dU; x ^= x >> 15; x *= 0x846ca68bU; x ^= x >> 16; return x; }
__device__ __forceinline__ float bfr(float x) { unsigned u = __float_as_uint(x); u += 0x7fffu + ((u >> 16) & 1u); return __uint_as_float(u & 0xffff0000u); }
#define DFAIL(code) do { if (__hip_atomic_load(dbg, __ATOMIC_RELAXED, __HIP_MEMORY_SCOPE_AGENT) == 0u) atomicCAS(dbg, 0u, (unsigned)(code)); } while (0)
#define DCHK(code, got, ref, rtol, atol) do { if (!close_((got), (ref), (rtol), (atol))) DFAIL(code); } while (0)
#endif

#define XB_TMO      128
#define XB_XCNT(j)  (256  + 64 * (j))
#define XB_XSUB(j)  (1280 + 64 * (j))
#define XB_XGEN(j)  (2304 + 64 * (j))
#define XB_TOP      3328
#define XB_TOPGEN   3392
#define XCD_BAR_WORDS 3456
#define XB_SPIN_CAP (1u << 22)
constexpr size_t WS_BAR = 9 * MiB + 16384;
constexpr int MISC_OFF = 131072 + 320;
__device__ __forceinline__ unsigned xb_ld(unsigned* p)              { return __hip_atomic_load(p, __ATOMIC_RELAXED, __HIP_MEMORY_SCOPE_AGENT); }
__device__ __forceinline__ unsigned xb_add(unsigned* p, unsigned v) { return __hip_atomic_fetch_add(p, v, __ATOMIC_RELAXED, __HIP_MEMORY_SCOPE_AGENT); }
__device__ __forceinline__ unsigned xb_xcc_id() { return (unsigned)__builtin_amdgcn_s_getreg((3 << 11) | 20) & 0xFu; }
#define XB_SPIN(cond, bar) do { unsigned _sp = 0; while (cond) { __builtin_amdgcn_s_sleep(1); \
    if ((++_sp & 255u) == 0u) { if (xb_ld(&(bar)[XB_TMO])) break; if (_sp > XB_SPIN_CAP) { atomicAdd(&(bar)[XB_TMO], 1u); break; } } } } while (0)
struct XcdBarrier { unsigned* bar; unsigned x; volatile LAS unsigned* st; };
__device__ __forceinline__ XcdBarrier xcd_barrier_post(unsigned* bar, volatile LAS unsigned* st) {
    XcdBarrier b; b.bar = bar; b.x = xb_xcc_id(); b.st = st;
    if (threadIdx.x == 0) (void)xb_add(&bar[XB_XCNT(b.x)], 1u);
    return b;
}
__device__ __forceinline__ void xcd_barrier_complete(unsigned* bar, unsigned x, unsigned& nloc, unsigned& nx) {
    const unsigned G = gridDim.x * gridDim.y * gridDim.z;
    unsigned sum, cnt, mine, sp = 0u;
    for (;;) {
        sum = 0u; cnt = 0u; mine = 0u;
#pragma unroll
        for (unsigned j = 0; j < 16; ++j) { const unsigned c = xb_ld(&bar[XB_XCNT(j)]); sum += c; cnt += (c > 0u) ? 1u : 0u; mine = (j == x) ? c : mine; }
        if (sum == G) break;
        __builtin_amdgcn_s_sleep(1);
        if ((++sp & 255u) == 0u) { if (xb_ld(&bar[XB_TMO])) break; if (sp > XB_SPIN_CAP) { atomicAdd(&bar[XB_TMO], 1u); break; } }
    }
    nloc = mine > 0u ? mine : 1u; nx = cnt > 0u ? cnt : 1u;
}
__device__ __forceinline__ void xcd_barrier(const XcdBarrier& b) {
    asm volatile("s_waitcnt vmcnt(0)" ::: "memory");
    __syncthreads();
    if (threadIdx.x == 0) {
        unsigned* bar = b.bar; unsigned bx = xb_xcc_id(); asm volatile("" : "+s"(bar), "+s"(bx));
        __builtin_amdgcn_s_waitcnt(0);
        unsigned nloc = b.st[0], nx = b.st[1];
        if (nloc == 0u) { xcd_barrier_complete(bar, bx, nloc, nx); b.st[0] = nloc; b.st[1] = nx; }
        const unsigned old = xb_add(&bar[XB_XSUB(bx)], 1u);
        const unsigned gen = old / nloc;
        if (old + 1u == (gen + 1u) * nloc) {
            __builtin_amdgcn_fence(__ATOMIC_RELEASE, "agent");
            asm volatile("s_waitcnt vmcnt(0)" ::: "memory");
            const unsigned og = xb_add(&bar[XB_TOP], 1u);
            const unsigned tg = og / nx;
            if (og + 1u == (tg + 1u) * nx) xb_add(&bar[XB_TOPGEN], 1u);
            else XB_SPIN(xb_ld(&bar[XB_TOPGEN]) == tg, bar);
            __builtin_amdgcn_fence(__ATOMIC_ACQUIRE, "agent");
            xb_add(&bar[XB_XGEN(bx)], 1u);
            asm volatile("s_waitcnt vmcnt(0)" ::: "memory");
        } else {
            XB_SPIN(xb_ld(&bar[XB_XGEN(bx)]) == gen, bar);
            __builtin_amdgcn_fence(__ATOMIC_ACQUIRE, "agent");
            asm volatile("s_waitcnt vmcnt(0)" ::: "memory");
        }
    }
    __syncthreads();
}

struct Args { const float* in[18]; float* out; unsigned char* ws; int ph_lo, ph_hi; };


#ifdef DBG
__device__ __forceinline__ void dbg_check(int p, const Args& args, int tid) {
    unsigned char* ws = args.ws; unsigned* dbg = (unsigned*)(ws + WS_DBG); float* dbuf = (float*)(ws + WS_DBGBUF);
    const float* x = args.in[0]; const float* ln_mix = args.in[1]; const float* ln_ffn = args.in[2]; float* out = args.out;
    const unsigned r = hsh(tid * 7u + 1u + 977u * (unsigned)p);
    if (p == 0) {
        { const int n = r % 2048, k = (r >> 11) % 1024; DCHK(10, bfv(WIN, (size_t)n * 1024 + k), args.in[4][(size_t)k * 2048 + n], 0.008f, 1e-6f); }
        { const int mat = r % 8, j = (r >> 3) % 256, k = (r >> 11) % 256; DCHK(11, bfv(WGA, (size_t)mat * 65536 + j * 256 + k), args.in[7][(size_t)mat * 65536 + k * 256 + j], 0.008f, 1e-6f);
          DCHK(11, bfv(WGX, (size_t)mat * 65536 + j * 256 + k), args.in[9][(size_t)mat * 65536 + k * 256 + j], 0.008f, 1e-6f); }
        { const int l = r & 1, n = (r >> 1) % FF, k = (r >> 13) % 1024; const float gv = ln_ffn[l * 1024 + k];
          DCHK(12, bfv(WFG, (size_t)l * FF * 1024 + (size_t)n * 1024 + k), args.in[15][(size_t)l * 1024 * FF + (size_t)k * FF + n] * gv, 0.008f, 1e-6f);
          DCHK(12, bfv(WFU, (size_t)l * FF * 1024 + (size_t)n * 1024 + k), args.in[16][(size_t)l * 1024 * FF + (size_t)k * FF + n] * gv, 0.008f, 1e-6f); }
        { const int l = r & 1, n = (r >> 1) % 1024, k = (r >> 11) % FF; DCHK(13, bfv(WFD, (size_t)l * FF * 1024 + (size_t)n * FF + k), args.in[17][(size_t)l * FF * 1024 + (size_t)k * 1024 + n], 0.008f, 1e-6f); }
        { const int n = r % 6144, k = (r >> 13) % 1024; const int col = n < 1024 ? n : (n < 3072 ? 4096 + (n - 1024) : (n < 4096 ? 1024 + (n - 3072) : 2048 + (n - 4096)));
          DCHK(14, bfv(WRI, (size_t)n * 1024 + k), args.in[13][(size_t)k * 6144 + col] * ln_mix[1024 + k], 0.008f, 1e-6f); }
        { const int row = r % T, col = (r >> 15) % 1024; float ss = 0.f; for (int k = 0; k < 1024; ++k) { const float v = x[(size_t)row * 1024 + k]; ss += v * v; }
          DCHK(15, bfv(XN, (size_t)row * 1024 + col), x[(size_t)row * 1024 + col] * (1.0f / sqrtf(ss / 1024.0f + EPS)) * ln_mix[col], 0.01f, 1e-5f); }
        { const int pos = r % 4096, j = (r >> 12) % 128; const double ang = (double)pos * exp(-((double)j / 127.0) * 9.210340371976184);
          DCHK(16, COST[pos * 128 + j], (float)cos(ang), 0.f, 2e-3f); DCHK(16, SINT[pos * 128 + j], (float)sin(ang), 0.f, 2e-3f);
          DCHK(16, COSJ[j * 4096 + pos], (float)cos(ang), 0.f, 2e-3f); DCHK(16, SINJ[j * 4096 + pos], (float)sin(ang), 0.f, 2e-3f); }
        { const int n = r % 1024, k = (r >> 10) % 1024; DCHK(17, bfv(WLO, (size_t)n * 1024 + k), args.in[12][(size_t)k * 1024 + n], 0.008f, 1e-6f);
          const int k2 = (r >> 10) % 2048; DCHK(17, bfv(WRO, (size_t)n * 2048 + k2), args.in[14][(size_t)k2 * 1024 + n], 0.008f, 1e-6f); }
    } else if (p == 1) {
        const int row = r % T, col = (r >> 15) % 2048; float ref = 0.f;
        for (int k = 0; k < 1024; ++k) ref += bfv(XN, (size_t)row * 1024 + k) * bfv(WIN, (size_t)col * 1024 + k);
        if (col < 1024) DCHK(20, bfv(XBP, (size_t)row * 1024 + col), ref, 0.01f, 2e-3f);
        else { const int ch = col - 1024, b = row >> 12, t = row & 4095; const float u = 0.7978845608f * (ref + 0.044715f * ref * ref * ref);
            DCHK(21, bfv(GG, ((size_t)((b * 32 + ch / 32) * 4096 + t)) * 32 + ch % 32), 0.5f * ref * (1.0f + tanhf(u)), 0.02f, 3e-3f); }
    } else if (p == 2) {
        const int row = r % T, ch = (r >> 15) % 1024, pos = row & 4095; float ref = args.in[6][ch];
        for (int j = 0; j < 4; ++j) { const int pp = pos + j - 2; if (pp >= 0 && pp < 4096) ref += args.in[5][j * 1024 + ch] * bfv(XBP, (size_t)(row + j - 2) * 1024 + ch); }
        DCHK(30, bfv(XB, (size_t)row * 1024 + ch), ref, 0.01f, 2e-3f);
    } else if (p == 3) {
        const int row = r % T, ch = (r >> 15) % 1024, d = (r >> 25) & 1, z = ch >> 8, j = ch & 255, b = row >> 12, t = row & 4095; float pa = args.in[8][d * 1024 + ch], px = args.in[10][d * 1024 + ch];
        for (int k = 0; k < 256; ++k) { const float xv = bfv(XB, (size_t)row * 1024 + z * 256 + k); pa += xv * bfv(WGA, (size_t)((d * 4 + z) * 256 + j) * 256 + k); px += xv * bfv(WGX, (size_t)((d * 4 + z) * 256 + j) * 256 + k); }
        const float rr = 1.0f / (1.0f + expf(-pa)), ii = 1.0f / (1.0f + expf(-px)); const float la2 = rr * CLA[d * 1024 + ch]; const float a = exp2f(la2);
        const float inp = ii * bfv(XB, (size_t)row * 1024 + ch); (void)a;
        const size_t off = ((size_t)((b * 32 + ch / 32) * 4096 + t)) * 32 + ch % 32;
        DCHK(40 + d, hfv(d ? LAB : LAF, off), la2, 0.02f, 1e-5f); DCHK(42 + d, bfv(d ? INB : INF, off), inp, 0.03f, 2e-3f);
        { const float lam = args.in[11][d * 1024 + ch]; DCHK(44, CLA[d * 1024 + ch], -8.0f * log1pf(expf(-lam)) * 1.4426950408889634f, 1e-3f, 1e-7f); }
    } else if (p == 4) {
        { const float* dc = dbuf + 16384; const int ch = tid & 31, sc = (tid >> 5) * 8 + (r % 8); const size_t sl = ch; float hf = 0.f, hb = 0.f;
          for (int q = 0; q < sc * 32; ++q) hf = ({ const float a_ = exp2f(hfv(LAF, sl + (size_t)q * 32)); a_ * hf + sqrtf(fmaxf(1.0f - a_ * a_, 0.f)) * bfv(INF, sl + (size_t)q * 32); });
          for (int q = 4095; q >= (sc + 1) * 32; --q) hb = ({ const float a_ = exp2f(hfv(LAB, sl + (size_t)q * 32)); a_ * hb + sqrtf(fmaxf(1.0f - a_ * a_, 0.f)) * bfv(INB, sl + (size_t)q * 32); });
          { const float* d2 = dbuf + 32768; float ls = 0.f, hl = 0.f; for (int q = sc * 32; q < sc * 32 + 32; ++q) { const float l = hfv(LAF, sl + (size_t)q * 32); ls += l; { const float a_ = exp2f(l); hl = a_ * hl + sqrtf(fmaxf(1.0f - a_ * a_, 0.f)) * bfv(INF, sl + (size_t)q * 32); } }
            DCHK(57, d2[sc * 32 + ch], ls, 0.01f, 1e-4f); DCHK(58, d2[4096 + sc * 32 + ch], hl, 0.02f, 1e-2f); }
          DCHK(sc == 0 ? 51 : (sc == 1 ? 54 : (sc < 8 ? 55 : 56)), dc[sc * 32 + ch], hf, 0.02f, 1e-2f); DCHK(52, dc[4096 + sc * 32 + ch], hb, 0.02f, 1e-2f);
          const int t = sc * 32 + ((r >> 3) & 31); hf = 0.f; hb = 0.f;
          for (int q = 0; q <= t; ++q) hf = ({ const float a_ = exp2f(hfv(LAF, sl + (size_t)q * 32)); a_ * hf + sqrtf(fmaxf(1.0f - a_ * a_, 0.f)) * bfv(INF, sl + (size_t)q * 32); });
          for (int q = 4095; q >= t; --q) hb = ({ const float a_ = exp2f(hfv(LAB, sl + (size_t)q * 32)); a_ * hb + sqrtf(fmaxf(1.0f - a_ * a_, 0.f)) * bfv(INB, sl + (size_t)q * 32); });
          DCHK(53, bfv(YL, (size_t)t * 1024 + ch), (hf + hb) * bfv(GG, sl + (size_t)t * 32), 0.03f, 3e-2f); }
        const int b = r % 8, ch = (r >> 3) % 1024, t = (r >> 13) % 4096; const size_t slab = ((size_t)(b * 32 + ch / 32) * 4096) * 32 + ch % 32; float hf = 0.f, hb = 0.f;
        for (int q = 0; q <= t; ++q) hf = ({ const float a_ = exp2f(hfv(LAF, slab + (size_t)q * 32)); a_ * hf + sqrtf(fmaxf(1.0f - a_ * a_, 0.f)) * bfv(INF, slab + (size_t)q * 32); });
        for (int q = 4095; q >= t; --q) hb = ({ const float a_ = exp2f(hfv(LAB, slab + (size_t)q * 32)); a_ * hb + sqrtf(fmaxf(1.0f - a_ * a_, 0.f)) * bfv(INB, slab + (size_t)q * 32); });
        DCHK(50, bfv(YL, (size_t)(b * 4096 + t) * 1024 + ch), (hf + hb) * bfv(GG, slab + (size_t)t * 32), 0.03f, 3e-2f);
    } else if (p == 5) {
        const int row = r % T, col = (r >> 15) % 1024; float ref = x[(size_t)row * 1024 + col];
        for (int k = 0; k < 1024; ++k) ref += bfv(YL, (size_t)row * 1024 + k) * bfv(WLO, (size_t)col * 1024 + k);
        DCHK(60, out[(size_t)row * 1024 + col], ref, 0.01f, 5e-3f); DCHK(61, bfv(XN, (size_t)row * 1024 + col), ref, 0.02f, 5e-3f);
        float ss = 0.f; for (int k = 0; k < 1024; ++k) { const float v = out[(size_t)row * 1024 + k]; ss += v * v; }
        DCHK(62, SS1[row], ss, 0.01f, 1e-3f);
    } else if (p == 6) {
        const int row = r % T, j = (r >> 15) % FF; float g = 0.f, u = 0.f;
        for (int k = 0; k < 1024; ++k) { const float xv = bfv(XN, (size_t)row * 1024 + k); g += xv * bfv(WFG, (size_t)j * 1024 + k); u += xv * bfv(WFU, (size_t)j * 1024 + k); }
        const float rs = 1.0f / sqrtf(SS1[row] / 1024.0f + EPS); g *= rs; u *= rs;
        DCHK(70, bfv(ACT, (size_t)row * FF + j), g / (1.0f + expf(-g)) * u, 0.03f, 5e-3f);
        { const unsigned r2 = hsh(tid * 7u + 1u + 977u * 7u); const int row2 = r2 % T, col2 = (r2 >> 15) % 1024; dbuf[tid] = out[(size_t)row2 * 1024 + col2]; }
    } else if (p == 7) {
        const int row = r % T, col = (r >> 15) % 1024; float ref = dbuf[tid];
        for (int k = 0; k < FF; ++k) ref += bfv(ACT, (size_t)row * FF + k) * bfv(WFD, (size_t)col * FF + k);
        DCHK(80, out[(size_t)row * 1024 + col], ref, 0.01f, 5e-3f);
    } else if (p == 8) {
        const int tl = r % TG, h = (r >> 13) % 4, j = (r >> 15) % 128, pos = tl & 4095, jt = tl & 255, bl = tl >> 12, cc = (tl >> 8) & 15, z = (bl * 4 + h) * 16 + cc;
        const float rs = 1.0f / sqrtf(SS2[tl] / 1024.0f + EPS); const float cv = COST[pos * 128 + j], sv = SINT[pos * 128 + j];
        const float lf = l2gam(h), lb = l2gam(3 - h);
        { float x1 = 0.f, x2 = 0.f; for (int k = 0; k < 1024; ++k) { const float xv = bfv(XN, (size_t)tl * 1024 + k); x1 += xv * bfv(WRI, (size_t)(h * 256 + j) * 1024 + k); x2 += xv * bfv(WRI, (size_t)(h * 256 + 128 + j) * 1024 + k); }
          x1 *= rs; x2 *= rs; const float o1 = x1 * cv - x2 * sv, o2 = x2 * cv + x1 * sv; const float wf = exp2f(lf * (float)(jt + 1)), wb = exp2f(lb * (float)(256 - jt));
          const size_t base = ((size_t)(z * 256 + jt)) * 768;
          DCHK(90, bfv(A2, base + 256 + j), o1 * wf, 0.02f, 1e-3f); DCHK(90, bfv(A2, base + 384 + j), o2 * wf, 0.02f, 1e-3f);
          DCHK(90, bfv(A2, base + 512 + j), o1 * wb, 0.02f, 1e-3f); DCHK(90, bfv(A2, base + 640 + j), o2 * wb, 0.02f, 1e-3f); }
        { float x1 = 0.f, x2 = 0.f; for (int k = 0; k < 1024; ++k) { const float xv = bfv(XN, (size_t)tl * 1024 + k); x1 += xv * bfv(WRI, (size_t)(3072 + h * 256 + j) * 1024 + k); x2 += xv * bfv(WRI, (size_t)(3072 + h * 256 + 128 + j) * 1024 + k); }
          x1 *= rs; x2 *= rs; const float o1 = (x1 * cv - x2 * sv) * 0.0625f, o2 = (x2 * cv + x1 * sv) * 0.0625f;
          DCHK(91, bfv(KB, (size_t)tl * 1024 + h * 256 + j), o1, 0.02f, 1e-3f); DCHK(91, bfv(KB, (size_t)tl * 1024 + h * 256 + 128 + j), o2, 0.02f, 1e-3f);
          const float wf = exp2f(lf * (float)(255 - jt)), wb = exp2f(lb * (float)jt);
          DCHK(92, bfv(KTF, (size_t)(h * 256 + j) * TG + tl), o1 * wf, 0.02f, 1e-3f); DCHK(92, bfv(KTF, (size_t)(h * 256 + 128 + j) * TG + tl), o2 * wf, 0.02f, 1e-3f);
          DCHK(92, bfv(KTB, (size_t)(h * 256 + j) * TG + tl), o1 * wb, 0.02f, 1e-3f); DCHK(92, bfv(KTB, (size_t)(h * 256 + 128 + j) * TG + tl), o2 * wb, 0.02f, 1e-3f); }
        { const int col = (r >> 13) % 2048; float gv = 0.f, vv = 0.f; for (int k = 0; k < 1024; ++k) { const float xv = bfv(XN, (size_t)tl * 1024 + k); gv += xv * bfv(WRI, (size_t)(1024 + col) * 1024 + k); vv += xv * bfv(WRI, (size_t)(4096 + col) * 1024 + k); }
          gv *= rs; vv *= rs; DCHK(93, bfv(SG, (size_t)tl * 2048 + col), gv / (1.0f + expf(-gv)), 0.03f, 2e-3f);
          const int hv = col >> 9, dv = col & 511, zv = (bl * 4 + hv) * 16 + cc; DCHK(94, bfv(BT2, ((size_t)(zv * 512 + dv)) * 768 + jt), vv, 0.02f, 2e-3f); }
    } else if (p == 9) {
        { const int z = r % 128, jn = (r >> 7) % 256, jm = (r >> 15) % 256, bl = z >> 6, h = (z >> 4) & 3, cc = z & 15; float sp = 0.f;
          for (int d = 0; d < 256; ++d) sp += bfv(A2, ((size_t)(z * 256 + jn)) * 768 + 256 + d) * bfv(KB, ((size_t)bl * 4096 + cc * 256 + jm) * 1024 + h * 256 + d);
          const float lf = l2gam(h), lb = l2gam(3 - h); const float f = (jm <= jn) ? exp2f(-lf * (float)(jm + 1)) : exp2f(-lf * (float)(jn + 1) + lb * (float)(jm - jn));
          DCHK(100, bfv(A2, ((size_t)(z * 256 + jn)) * 768 + jm), sp * f, 0.02f, 2e-3f); }
        { const int z = r % 128, dir = (r >> 7) & 1, dv = (r >> 8) % 512, dk = (r >> 17) % 256, bl = z >> 6, h = (z >> 4) & 3, cc = z & 15; float kv = 0.f; const bf16_t* kt = dir ? KTB : KTF;
          for (int m = 0; m < 256; ++m) kv += bfv(BT2, ((size_t)(z * 512 + dv)) * 768 + m) * bfv(kt, (size_t)(h * 256 + dk) * TG + bl * 4096 + cc * 256 + m);
          DCHK(101, bfv(BT2, ((size_t)(z * 512 + dv)) * 768 + 256 + dir * 256 + dk), kv, 0.02f, 2e-3f);
          const int bh = z >> 4; for (int q = 0; q < 16; ++q) dbuf[tid * 16 + q] = bfv(BT2, ((size_t)((bh * 16 + q) * 512 + dv)) * 768 + 256 + dir * 256 + dk); }
    } else if (p == 10) {
        const unsigned r9 = hsh(tid * 7u + 1u + 977u * 9u); const int z = r9 % 128, dir = (r9 >> 7) & 1, dv = (r9 >> 8) % 512, dk = (r9 >> 17) % 256, bh = z >> 4, h = bh & 3;
        const float gch = exp2f(256.0f * l2gam(dir ? 3 - h : h)); float st = 0.f;
        if (dir == 0) { for (int q = 0; q < 16; ++q) { DCHK(110, bfv(BT2, ((size_t)((bh * 16 + q) * 512 + dv)) * 768 + 256 + dk), st, 0.02f, 2e-3f); st = st * gch + dbuf[tid * 16 + q]; } }
        else { for (int q = 15; q >= 0; --q) { DCHK(111, bfv(BT2, ((size_t)((bh * 16 + q) * 512 + dv)) * 768 + 512 + dk), st, 0.02f, 2e-3f); st = st * gch + dbuf[tid * 16 + q]; } }
    } else if (p == 11) {
        const int z = r % 128, jn = (r >> 7) % 256, dv = (r >> 15) % 512, bl = z >> 6, h = (z >> 4) & 3, cc = z & 15, tok = bl * 4096 + cc * 256 + jn; float y = 0.f;
        for (int k = 0; k < 768; ++k) y += bfv(A2, ((size_t)(z * 256 + jn)) * 768 + k) * bfv(BT2, ((size_t)(z * 512 + dv)) * 768 + k);
        DCHK(120, bfv(YZ, (size_t)tok * 2048 + h * 512 + dv), y, 0.02f, 3e-3f);
        float ssq = 0.f; for (int e = 0; e < 512; ++e) { const float v = bfv(YZ, (size_t)tok * 2048 + h * 512 + e); ssq += v * v; }
        DCHK(121, YSS[tok * 4 + h], ssq, 0.03f, 1e-4f);
        dbuf[8192 + tid] = bfv(YZ, (size_t)tok * 2048 + h * 512 + dv);
        if (tid < 64) {
            const float lf = l2gam(h), lb = l2gam(3 - h); const int n = cc * 256 + jn; float acc = 0.f;
            for (int m = 0; m < 4096; ++m) { float qk = 0.f; for (int d = 0; d < 256; ++d) qk += bfv(A2, ((size_t)(z * 256 + jn)) * 768 + 256 + d) * bfv(KB, ((size_t)bl * 4096 + m) * 1024 + h * 256 + d);
                const float w = (m <= n) ? exp2f(lf * (float)(n - m - jn - 1)) : exp2f(lb * (float)(m - n) - lf * (float)(jn + 1));
                const int zm = (bl * 4 + h) * 16 + (m >> 8); acc += qk * w * bfv(BT2, ((size_t)(zm * 512 + dv)) * 768 + (m & 255)); }
            DCHK(125, bfv(YZ, (size_t)tok * 2048 + h * 512 + dv), acc, 0.05f, 1e-2f); }
    } else if (p == 12) {
        const unsigned r11 = hsh(tid * 7u + 1u + 977u * 11u); const int z = r11 % 128, jn = (r11 >> 7) % 256, dv = (r11 >> 15) % 512, bl = z >> 6, h = (z >> 4) & 3, cc = z & 15, tok = bl * 4096 + cc * 256 + jn;
        const float rs = 1.0f / sqrtf(YSS[tok * 4 + h] / 512.0f + EPS);
        DCHK(130, bfv(YZ, (size_t)tok * 2048 + h * 512 + dv), dbuf[8192 + tid] * rs * bfv(SG, (size_t)tok * 2048 + h * 512 + dv), 0.02f, 2e-3f);
    } else if (p == 27) {
        const unsigned r2 = hsh(tid * 7u + 1u + 977u * 28u); const int row2 = r2 % T, col2 = (r2 >> 15) % 1024; dbuf[9216 + tid] = out[(size_t)row2 * 1024 + col2];
    } else if (p == 28) {
        const int row = r % T, col = (r >> 15) % 1024; float ref = dbuf[9216 + tid];
        for (int k = 0; k < 2048; ++k) ref += bfv(YZ, (size_t)row * 2048 + k) * bfv(WRO, (size_t)col * 2048 + k);
        DCHK(140, out[(size_t)row * 1024 + col], ref, 0.01f, 5e-3f);
    } else if (p == 29) {
        const int row = r % T, j = (r >> 15) % FF; float g = 0.f, u = 0.f;
        for (int k = 0; k < 1024; ++k) { const float xv = bfv(XN, (size_t)row * 1024 + k); g += xv * bfv(WFG, (size_t)FF * 1024 + (size_t)j * 1024 + k); u += xv * bfv(WFU, (size_t)FF * 1024 + (size_t)j * 1024 + k); }
        const float rs = 1.0f / sqrtf(SS3[row] / 1024.0f + EPS); g *= rs; u *= rs;
        DCHK(150, bfv(ACT, (size_t)row * FF + j), g / (1.0f + expf(-g)) * u, 0.03f, 5e-3f);
        { const unsigned r2 = hsh(tid * 7u + 1u + 977u * 30u); const int row2 = r2 % T, col2 = (r2 >> 15) % 1024; dbuf[9728 + tid] = out[(size_t)row2 * 1024 + col2]; }
    } else if (p == 30) {
        const int row = r % T, col = (r >> 15) % 1024; float ref = dbuf[9728 + tid];
        for (int k = 0; k < FF; ++k) ref += bfv(ACT, (size_t)row * FF + k) * bfv(WFD, (size_t)FF * 1024 + (size_t)col * FF + k);
        DCHK(160, out[(size_t)row * 1024 + col], ref, 0.01f, 5e-3f);
        { const unsigned r2 = hsh(tid * 7u + 1u + 977u * 31u); const int row2 = r2 % T, col2 = (r2 >> 15) % 1024; dbuf[10240 + tid] = out[(size_t)row2 * 1024 + col2]; }
    } else if (p == 31) {
        const int row = r % T, col = (r >> 15) % 1024;
        DCHK(170, out[(size_t)row * 1024 + col], dbuf[10240 + tid] * (1.0f / sqrtf(SS4[row] / 1024.0f + EPS)) * args.in[3][col], 0.01f, 1e-3f);
    }
}
__global__ void __launch_bounds__(512) dbg_kernel(Args args, int p) { dbg_check(p, args, (int)threadIdx.x); }
__global__ void __launch_bounds__(512) dbg_emit(Args args) { const unsigned code = *(const unsigned*)(args.ws + WS_DBG);
    if (code) for (int i = blockIdx.x * 512 + threadIdx.x; i < T * D; i += gridDim.x * 512) args.out[i] = 10.0f * (float)code; }
#endif

__global__ void __launch_bounds__(512, 2) mk_fwd(Args args) {
    extern __shared__ __attribute__((aligned(16))) unsigned char lds_raw[];
    LAS unsigned char* lds = (LAS unsigned char*)lds_raw;
    cg::grid_group grid = cg::this_grid();
    const int G = gridDim.x, c = blockIdx.x, NGW = G * 8, NGT = G * 512;
#define PH_VARS int tid = threadIdx.x; asm volatile("" : "+v"(tid)); const int lane = tid & 63, wave = __builtin_amdgcn_readfirstlane(tid >> 6), gw = c * 8 + wave, gt = c * 512 + tid; (void)lane; (void)gw; (void)gt;
    unsigned char* ws = args.ws;
    const float* x = args.in[0]; const float* ln_mix = args.in[1]; const float* ln_ffn = args.in[2]; const float* ln_fin = args.in[3];
    float* out = args.out;
#ifdef DBG
    const int lo = args.ph_lo, hi = args.ph_hi;
    int p = 0;
#endif
#define PH_ON (p >= lo && p < hi)
    volatile LAS unsigned* MISC = (volatile LAS unsigned*)(lds + MISC_OFF);
    if (threadIdx.x < 32) MISC[threadIdx.x] = 0u;
    __syncthreads();
    XcdBarrier xbar; xbar.bar = (unsigned*)(ws + WS_BAR); xbar.x = 0; xbar.st = MISC + 8;
#ifndef DBG
    xbar = xcd_barrier_post((unsigned*)(ws + WS_BAR), MISC + 8);
    if (args.ph_lo < 0) grid.sync();
#endif
#ifdef DBG
#define PH_END do { if (PH_ON && p + 1 < hi) { if (p == 0) { grid.sync(); xbar = xcd_barrier_post((unsigned*)(ws + WS_BAR), MISC + 8); } else xcd_barrier(xbar); } ++p; } while (0)
#define PH_END0 PH_END
#define PH_FINAL PH_END
#else
#undef PH_ON
#define PH_ON true
#define PH_END0 xcd_barrier(xbar)
#define PH_END xcd_barrier(xbar)
#define PH_FINAL do { } while (0)
#endif

    for (int rep_ = 0; rep_ < ((PH_ON && PHX(0)) ? NREP(0) : 0); ++rep_) { PH_VARS
#ifdef DBG
        if (gt == 0) *(unsigned*)(ws + WS_DBG) = 0u;
#endif
#ifdef DBG
        if (gt < XCD_BAR_WORDS) ((unsigned*)(ws + WS_BAR))[gt] = 0u;
#endif
        for (int i = gt; i < 4096 * 128; i += NGT) { const int pos = i >> 7, j = i & 127;
            const float invf = ex2(-(float)j * (13.287712379549449f / 127.0f)); const float ang = (float)pos * invf;
            double rd = (double)ang * 0.15915494309189535; rd -= floor(rd); const float fr_ = (float)rd;
            COST[i] = __builtin_amdgcn_cosf(fr_); SINT[i] = __builtin_amdgcn_sinf(fr_); }
        for (int i = gt; i < 4096 * 128; i += NGT) { const int j = i >> 12, pos = i & 4095;
            const float invf = ex2(-(float)j * (13.287712379549449f / 127.0f)); const float ang = (float)pos * invf;
            double rd = (double)ang * 0.15915494309189535; rd -= floor(rd); const float fr_ = (float)rd;
            COSJ[i] = __builtin_amdgcn_cosf(fr_); SINJ[i] = __builtin_amdgcn_sinf(fr_); }
        for (int i = gt; i < 2048; i += NGT) { const float lam = args.in[11][i]; CLA[i] = -8.0f * log1pf(expf(-lam)) * 1.4426950408889634f; }
        LAS float* scr = (LAS float*)(lds + wave * 16384);
#define TR_DECODE(IT0, W, ldw, K, N, WT, gain, it) do { it = (IT0); gain = nullptr; \
            if (it < 1024) { W = args.in[4]; ldw = 2048; K = 1024; N = 2048; WT = WIN; } \
            else if ((it -= 1024) < 512) { const int mat = it >> 5; it &= 31; W = (mat < 8 ? args.in[7] : args.in[9]) + (size_t)(mat & 7) * 65536; WT = (mat < 8 ? WGA : WGX) + (size_t)(mat & 7) * 65536; ldw = 256; K = 256; N = 256; } \
            else if ((it -= 512) < 512) { W = args.in[12]; ldw = 1024; K = 1024; N = 1024; WT = WLO; } \
            else if ((it -= 512) < 8448) { const int q = it / 1408; it -= q * 1408; const int l = q / 3, w = q - l * 3; \
                if (w == 0) { W = args.in[15] + (size_t)l * 1024 * FF; ldw = FF; K = 1024; N = FF; WT = WFG + (size_t)l * FF * 1024; gain = ln_ffn + l * 1024; } \
                else if (w == 1) { W = args.in[16] + (size_t)l * 1024 * FF; ldw = FF; K = 1024; N = FF; WT = WFU + (size_t)l * FF * 1024; gain = ln_ffn + l * 1024; } \
                else { W = args.in[17] + (size_t)l * 1024 * FF; ldw = 1024; K = FF; N = 1024; WT = WFD + (size_t)l * FF * 1024; } } \
            else if ((it -= 8448) < 3072) { ldw = 6144; K = 1024; gain = ln_mix + 1024; \
                if (it < 512) { W = args.in[13]; N = 1024; WT = WRI; } \
                else if ((it -= 512) < 512) { W = args.in[13] + 1024; N = 1024; WT = WRI + (size_t)3072 * 1024; } \
                else if ((it -= 512) < 1024) { W = args.in[13] + 2048; N = 2048; WT = WRI + (size_t)4096 * 1024; } \
                else { it -= 1024; W = args.in[13] + 4096; N = 2048; WT = WRI + (size_t)1024 * 1024; } } \
            else { it -= 3072; W = args.in[14]; ldw = 1024; K = 2048; N = 1024; WT = WRO; } } while (0)
        if (gw < 14592) {
            const float* W; const float* gain; bf16_t* WT; int ldw, K, N, it; f32x4 v[8];
            TR_DECODE(gw, W, ldw, K, N, WT, gain, it); tr_load(W, ldw, N / 32, it, lane, v);
            for (int it0 = gw; it0 < 14592; it0 += NGW) {
                const float* W2 = W; const float* gain2 = gain; bf16_t* WT2 = WT; int ldw2 = ldw, K2 = K, N2 = N, it2 = it; f32x4 v2[8];
                const bool more = it0 + NGW < 14592;
                if (more) { TR_DECODE(it0 + NGW, W2, ldw2, K2, N2, WT2, gain2, it2); tr_load(W2, ldw2, N2 / 32, it2, lane, v2); }
                tr_finish(v, K, N / 32, WT, scr, it, lane, gain);
                if (more) { W = W2; gain = gain2; WT = WT2; ldw = ldw2; K = K2; N = N2; it = it2;
#pragma unroll
                    for (int i = 0; i < 8; ++i) v[i] = v2[i]; }
            }
        }
#undef TR_DECODE
        for (int row = gw; row < T; row += 2 * NGW) {
            const int row2 = row + NGW; const bool has2 = row2 < T;
            const f32x4* xr = (const f32x4*)(x + (size_t)row * 1024) + lane; const f32x4* xr2 = (const f32x4*)(x + (size_t)(has2 ? row2 : row) * 1024) + lane;
            f32x4 v[4], v2[4]; float s = 0.f, s2 = 0.f;
#pragma unroll
            for (int j = 0; j < 4; ++j) { v[j] = xr[64 * j]; v2[j] = xr2[64 * j]; }
#pragma unroll
            for (int j = 0; j < 4; ++j) { s += (v[j][0] * v[j][0] + v[j][1] * v[j][1]) + (v[j][2] * v[j][2] + v[j][3] * v[j][3]); s2 += (v2[j][0] * v2[j][0] + v2[j][1] * v2[j][1]) + (v2[j][2] * v2[j][2] + v2[j][3] * v2[j][3]); }
            const float rs = rsq(wave_sum(s) * (1.0f / 1024.0f) + EPS), rs2 = rsq(wave_sum(s2) * (1.0f / 1024.0f) + EPS);
#pragma unroll
            for (int j = 0; j < 4; ++j) { const f32x4 gv = ((const f32x4*)ln_mix)[64 * j + lane]; const f32x4 o = v[j] * rs * gv, o2 = v2[j] * rs2 * gv;
                uint2 w; w.x = cvt_pk_bf16(o[0], o[1]); w.y = cvt_pk_bf16(o[2], o[3]); *(uint2*)(XN + (size_t)row * 1024 + (64 * j + lane) * 4) = w;
                if (has2) { uint2 w2; w2.x = cvt_pk_bf16(o2[0], o2[1]); w2.y = cvt_pk_bf16(o2[2], o2[3]); *(uint2*)(XN + (size_t)row2 * 1024 + (64 * j + lane) * 4) = w2; } }
        }
    }
    PH_END0;

    for (int rep_ = 0; rep_ < ((PH_ON && PHX(1)) ? NREP(1) : 0); ++rep_) {
        StdSched S{(const char*)XN, (const char*)WIN, 128, 8, 1024, 1024, G, c}; EpiP1 E{XBP, GG};
        pg8::gemm_phase(lds, 1024, 1024, 1024, S, E);
    }
    PH_END;

#ifdef EXTRA_BAR
    for (int eb_ = 0; eb_ < EXTRA_BAR; ++eb_) xcd_barrier(xbar);
#endif
    for (int rep_ = 0; rep_ < ((PH_ON && PHX(2)) ? NREP(2) : 0); ++rep_) { PH_VARS
        const float* cw = args.in[5]; const float* cb = args.in[6];
        for (int it = gt; it < 1024 * 128; it += NGT) {
            const int o = it & 127, s = it >> 7, t0 = s * 32, ch = o * 8, p0 = t0 & 4095;
            f32x4 w[4][2];
#pragma unroll
            for (int j = 0; j < 4; ++j) { w[j][0] = *(const f32x4*)(cw + j * 1024 + ch); w[j][1] = *(const f32x4*)(cw + j * 1024 + ch + 4); }
            const f32x4 b0 = *(const f32x4*)(cb + ch), b1 = *(const f32x4*)(cb + ch + 4);
            const bf16_t* src = XBP + (size_t)t0 * 1024 + ch; bf16_t* dst = XB + (size_t)t0 * 1024 + ch;
            const f32x4 zz = (f32x4){0.f, 0.f, 0.f, 0.f};
            f32x4 m2l = zz, m2h = zz, m1l = zz, m1h = zz, c0l, c0h;
            if (p0 != 0) { const u32x4 a = *(const u32x4*)(src - 2048), bq = *(const u32x4*)(src - 1024); m2l = unlo(a); m2h = unhi(a); m1l = unlo(bq); m1h = unhi(bq); }
            { const u32x4 a = *(const u32x4*)(src); c0l = unlo(a); c0h = unhi(a); }
#pragma unroll 8
            for (int i = 0; i < 32; ++i) {
                f32x4 p1l = zz, p1h = zz;
                if (p0 + i + 1 < 4096) { const u32x4 a = *(const u32x4*)(src + (size_t)(i + 1) * 1024); p1l = unlo(a); p1h = unhi(a); }
                const f32x4 yl = w[0][0] * m2l + w[1][0] * m1l + w[2][0] * c0l + w[3][0] * p1l + b0;
                const f32x4 yh = w[0][1] * m2h + w[1][1] * m1h + w[2][1] * c0h + w[3][1] * p1h + b1;
                ST16((dst + (size_t)i * 1024), pack8(yl, yh));
                m2l = m1l; m2h = m1h; m1l = c0l; m1h = c0h; c0l = p1l; c0h = p1h;
            }
        }
    }
    PH_END;

    for (int rep_ = 0; rep_ < ((PH_ON && PHX(3)) ? NREP(3) : 0); ++rep_) {
        GateSched S{(const char*)XB, (const char*)WGA, (const char*)WGX, G, c};
        EpiGate E{XB, args.in[8], args.in[10], CLA, LAF, INF, LAB, INB};
        pg8::gemm_phase(lds, 1024, 256, 256, S, E);
    }
    PH_END;

    for (int rep_ = 0; rep_ < ((PH_ON && PHX(4)) ? NREP(4) : 0); ++rep_) { PH_VARS
        const int o = tid & 3, s = tid >> 2;
        LAS float* CL = (LAS float*)lds; LAS float* CH = CL + 2 * 128 * 32;
        for (int it_ = c; it_ < 256; it_ += G) {
            const int item = (G == 256) ? ((it_ & 7) * 32 + (it_ >> 3)) : it_;
            const size_t slab = (size_t)item * 4096 * 32 + o * 8; const int b = item >> 5, cgp = item & 31;
            float L[8], H[8];
#pragma unroll
            for (int dir = 0; dir < 2; ++dir) {
#pragma unroll
                for (int k = 0; k < 8; ++k) { L[k] = 0.f; H[k] = 0.f; }
                const unsigned short* pl = (dir ? LAB : LAF) + slab + (size_t)s * 1024; const bf16_t* pq = (dir ? INB : INF) + slab + (size_t)s * 1024;
                asm volatile("" : "+v"(pl), "+v"(pq));
                u32x4 lbuf[2][4], qbuf[2][4];
#pragma unroll
                for (int j = 0; j < 4; ++j) { const int r0 = (dir ? 28 : 0) + j; lbuf[0][j] = *(const u32x4*)(pl + r0 * 32); qbuf[0][j] = *(const u32x4*)(pq + r0 * 32); }
#pragma unroll
                for (int gi = 0; gi < 8; ++gi) { const int gg_ = dir ? 7 - gi : gi;
                    if (gi < 7) { const int gn = dir ? gg_ - 1 : gg_ + 1;
#pragma unroll
                        for (int j = 0; j < 4; ++j) { lbuf[(gi + 1) & 1][j] = *(const u32x4*)(pl + (gn * 4 + j) * 32); qbuf[(gi + 1) & 1][j] = *(const u32x4*)(pq + (gn * 4 + j) * 32); } }
#pragma unroll
                    for (int jj = 0; jj < 4; ++jj) { const int j = dir ? 3 - jj : jj; const u32x4 lw = lbuf[gi & 1][j], iw = qbuf[gi & 1][j];
                        const f32x4 l0 = unlo_h(lw), l1 = unhi_h(lw), q0 = unlo(iw), q1 = unhi(iw);
#pragma unroll
                        for (int k = 0; k < 4; ++k) { lru_step(l0[k], q0[k], H[k]); L[k] += l0[k]; lru_step(l1[k], q1[k], H[4 + k]); L[4 + k] += l1[k]; } }
                    __builtin_amdgcn_sched_barrier(0); }
#pragma unroll
                for (int k = 0; k < 8; ++k) { CL[(dir * 128 + s) * 32 + o * 8 + k] = L[k]; CH[(dir * 128 + s) * 32 + o * 8 + k] = H[k]; }
            }
            __syncthreads();
#ifdef DBG
            if (item == 0) { float* dc = (float*)(ws + WS_DBGBUF) + 32768;
#pragma unroll
                for (int k = 0; k < 8; ++k) { dc[s * 32 + o * 8 + k] = CL[s * 32 + o * 8 + k]; dc[4096 + s * 32 + o * 8 + k] = CH[s * 32 + o * 8 + k]; } }
            __syncthreads();
#endif
            if (tid < 64) { const int dir = tid >> 5, ch = tid & 31; float cr = 0.f;
                if (dir == 0) { for (int q = 0; q < 128; ++q) { const int idx = q * 32 + ch; const float l = CL[idx], hh = CH[idx]; CH[idx] = cr; cr = ex2(l) * cr + hh; } }
                else { for (int q = 127; q >= 0; --q) { const int idx = (128 + q) * 32 + ch; const float l = CL[idx], hh = CH[idx]; CH[idx] = cr; cr = ex2(l) * cr + hh; } } }
            __syncthreads();
#ifdef DBG
            if (item == 0) { float* dc = (float*)(ws + WS_DBGBUF) + 16384;
#pragma unroll
                for (int k = 0; k < 8; ++k) { dc[s * 32 + o * 8 + k] = CH[s * 32 + o * 8 + k]; dc[4096 + s * 32 + o * 8 + k] = CH[(128 + s) * 32 + o * 8 + k]; } }
#endif
#pragma unroll
            for (int k = 0; k < 8; ++k) H[k] = CH[s * 32 + o * 8 + k];
            u32x4 hfp[32];
            {
                const unsigned short* pl = LAF + slab + (size_t)s * 1024; const bf16_t* pi = INF + slab + (size_t)s * 1024;
                asm volatile("" : "+v"(pl), "+v"(pi));
                u32x4 lbuf[2][4], qbuf[2][4];
#pragma unroll
                for (int j = 0; j < 4; ++j) { lbuf[0][j] = *(const u32x4*)(pl + j * 32); qbuf[0][j] = *(const u32x4*)(pi + j * 32); }
#pragma unroll
                for (int gi = 0; gi < 8; ++gi) {
                    if (gi < 7) {
#pragma unroll
                        for (int j = 0; j < 4; ++j) { lbuf[(gi + 1) & 1][j] = *(const u32x4*)(pl + ((gi + 1) * 4 + j) * 32); qbuf[(gi + 1) & 1][j] = *(const u32x4*)(pi + ((gi + 1) * 4 + j) * 32); } }
#pragma unroll
                    for (int j = 0; j < 4; ++j) { const u32x4 lw = lbuf[gi & 1][j], iw = qbuf[gi & 1][j];
                        const f32x4 l0 = unlo_h(lw), l1 = unhi_h(lw), q0 = unlo(iw), q1 = unhi(iw); f32x4 h0, h1;
#pragma unroll
                        for (int k = 0; k < 4; ++k) { lru_step(l0[k], q0[k], H[k]); lru_step(l1[k], q1[k], H[4 + k]); h0[k] = H[k]; h1[k] = H[4 + k]; }
                        hfp[gi * 4 + j] = pack8(h0, h1); }
                    __builtin_amdgcn_sched_barrier(0); }
            }
#pragma unroll
            for (int k = 0; k < 8; ++k) H[k] = CH[(128 + s) * 32 + o * 8 + k];
            {
                const unsigned short* pl = LAB + slab + (size_t)s * 1024; const bf16_t* pi = INB + slab + (size_t)s * 1024; const bf16_t* pg = GG + slab + (size_t)s * 1024;
                bf16_t* yp = YL + (size_t)(b * 4096 + s * 32 + 31) * 1024 + cgp * 32 + o * 8;
                asm volatile("" : "+v"(pl), "+v"(pi), "+v"(pg), "+v"(yp));
                u32x4 lbuf[2][2], qbuf[2][2], gbuf[2][2];
#pragma unroll
                for (int j = 0; j < 2; ++j) { lbuf[0][j] = *(const u32x4*)(pl + (30 + j) * 32); qbuf[0][j] = *(const u32x4*)(pi + (30 + j) * 32); gbuf[0][j] = *(const u32x4*)(pg + (30 + j) * 32); }
#pragma unroll
                for (int gi = 0; gi < 16; ++gi) { const int g2 = 15 - gi;
                    if (gi < 15) {
#pragma unroll
                        for (int j = 0; j < 2; ++j) { const int r_ = (g2 - 1) * 2 + j; lbuf[(gi + 1) & 1][j] = *(const u32x4*)(pl + r_ * 32); qbuf[(gi + 1) & 1][j] = *(const u32x4*)(pi + r_ * 32); gbuf[(gi + 1) & 1][j] = *(const u32x4*)(pg + r_ * 32); } }
#pragma unroll
                    for (int jj = 0; jj < 2; ++jj) { const int j = 1 - jj, i = g2 * 2 + j; const u32x4 lw = lbuf[gi & 1][j], iw = qbuf[gi & 1][j], gwv = gbuf[gi & 1][j], fw = hfp[i];
                        const f32x4 l0 = unlo_h(lw), l1 = unhi_h(lw), q0 = unlo(iw), q1 = unhi(iw), g0 = unlo(gwv), g1 = unhi(gwv), f0 = unlo(fw), f1 = unhi(fw); f32x4 y0, y1;
#pragma unroll
                        for (int k = 0; k < 4; ++k) { lru_step(l0[k], q0[k], H[k]); lru_step(l1[k], q1[k], H[4 + k]); y0[k] = (f0[k] + H[k]) * g0[k]; y1[k] = (f1[k] + H[4 + k]) * g1[k]; }
                        ST16(yp, pack8(y0, y1)); yp -= 1024; asm volatile("" : "+v"(yp)); }
                    if (gi & 1) __builtin_amdgcn_sched_barrier(0); }
            }
            __syncthreads();
        }
    }
    PH_END;

    for (int rep_ = 0; rep_ < ((PH_ON && PHX(5)) ? NREP(5) : 0); ++rep_) {
        StdSched S{(const char*)YL, (const char*)WLO, 128, 4, 1024, 1024, G, c}; EpiRes<true> E{x, XN, SS1, nullptr};
        pg8::gemm_phase(lds, 1024, 1024, 1024, S, E);
    }
    PH_END;
    for (int rep_ = 0; rep_ < ((PH_ON && PHX(6)) ? NREP(6) : 0); ++rep_) {
        FfnUpSched S{(const char*)XN, (const char*)WFG, (const char*)WFU, G, c}; EpiFfnUp E{SS1, ACT};
        pg8::gemm_phase(lds, 1024, 1024, 1024, S, E);
    }
    PH_END;
    for (int rep_ = 0; rep_ < ((PH_ON && PHX(7)) ? NREP(7) : 0); ++rep_) {
        StdSched S{(const char*)ACT, (const char*)WFD, 128, 4, FF, FF, G, c}; EpiRes<false> E{nullptr, XN, SS2, nullptr};
        pg8::gemm_phase(lds, FF, FF, FF, S, E);
    }
    PH_END;

#define NORM_PASS(gg) do { _Pragma("unroll 4") for (int it = gt; it < TG * 256; it += NGT) { const int row = it >> 8, o = it & 255, h = o >> 6; const int tok = (gg) * TG + row; \
        const float* yq_ = YSS + (size_t)(tok * 4 + h) * 8; const f32x4 ya_ = *(const f32x4*)yq_ + *(const f32x4*)(yq_ + 4); const float rs = rsq(((ya_[0] + ya_[1]) + (ya_[2] + ya_[3])) * (1.0f / 512.0f) + EPS); bf16_t* yp = YZ + (size_t)tok * 2048 + o * 8; const u32x4 yw = *(const u32x4*)yp; \
        ST16(yp, pack8(unlo(yw) * rs, unhi(yw) * rs)); } } while (0)
    for (int g = 0; g < NGRP; ++g) {
        const bf16_t* XNg = XN + (size_t)g * TG * 1024;
        for (int rep_ = 0; rep_ < ((PH_ON && PHX(8)) ? NREP(8) : 0); ++rep_) {
            if (SUBMASK & 1u) { StdSched S{(const char*)XNg, (const char*)WRI, 32, 16, 1024, 1024, G, c}; EpiRetA E{SS2, COST, SINT, A2, SG, KB, g};
              pg8::gemm_phase(lds, 1024, 1024, 1024, S, E); }
            if (SUBMASK & 2u) { StdSched S{(const char*)(WRI + (size_t)4096 * 1024), (const char*)XNg, 8, 32, 1024, 1024, G, c}; EpiRetB E{SS2, BT2, g};
              pg8::gemm_phase(lds, 1024, 1024, 1024, S, E); }
        }
        PH_END;
        for (int rep_ = 0; rep_ < ((PH_ON && PHX(9)) ? NREP(9) : 0); ++rep_) {
            { ScoreSched S{(const char*)A2, (const char*)KB, G, c}; EpiScore E{A2}; pg8::gemm_phase(lds, 768, 1024, 256, S, E); }
            const bool split = G >= 256;
            if (!split || c >= 128) { PH_VARS
                const int w0 = split ? (c - 128) * 8 + wave : gw, wst = split ? (G - 128) * 8 : NGW;
                LAS bf16_t* tb = (LAS bf16_t*)(lds + wave * 16384);
                for (int tile = w0; tile < 128 * 16; tile += wst) {
                    const int t0 = (tile >> 4) * 64, d0 = (tile & 15) * 64, h = d0 >> 8; const float lf = l2gam(h), lb = l2gam(3 - h);
#pragma unroll
                    for (int i = 0; i < 8; ++i) { const int row = i * 8 + (lane >> 3), cp = lane & 7;
                        *(LAS u32x4*)(tb + row * 72 + cp * 8) = *(const u32x4*)(KB + (size_t)(t0 + row) * 1024 + d0 + cp * 8); }
                    asm volatile("s_waitcnt lgkmcnt(0)" ::: "memory");
                    const int tp = lane & 7, jt0 = (t0 & 255) + tp * 8;
                    f32x4 wf0, wf1, wb0, wb1;
#pragma unroll
                    for (int e = 0; e < 4; ++e) { wf0[e] = ex2(lf * (float)(255 - (jt0 + e))); wf1[e] = ex2(lf * (float)(255 - (jt0 + 4 + e))); wb0[e] = ex2(lb * (float)(jt0 + e)); wb1[e] = ex2(lb * (float)(jt0 + 4 + e)); }
#pragma unroll
                    for (int i = 0; i < 8; ++i) { const int col = i * 8 + (lane >> 3); f32x4 k0, k1;
#pragma unroll
                        for (int e = 0; e < 4; ++e) { k0[e] = __uint_as_float((unsigned)tb[(tp * 8 + e) * 72 + col] << 16); k1[e] = __uint_as_float((unsigned)tb[(tp * 8 + 4 + e) * 72 + col] << 16); }
                        const size_t o = (size_t)(d0 + col) * TG + t0 + tp * 8;
                        ST16((KTF + o), pack8(k0 * wf0, k1 * wf1)); ST16((KTB + o), pack8(k0 * wb0, k1 * wb1)); }
                    asm volatile("s_waitcnt lgkmcnt(0)" ::: "memory");
                }
            }
        }
        PH_END;
        for (int rep_ = 0; rep_ < ((PH_ON && PHX(12)) ? NREP(12) : 0); ++rep_) {
            KvSched S{(const char*)BT2, (const char*)KTF, (const char*)KTB, G, c}; EpiKv E{BT2}; pg8::gemm_phase(lds, 768, TG, 256, S, E);
        }
        PH_END;
        for (int rep_ = 0; rep_ < ((PH_ON && PHX(10)) ? NREP(10) : 0); ++rep_) { PH_VARS
            for (int it_ = gt; it_ < 262144; it_ += NGT) {
                const int it = (G == 256) ? (((c & 7) << 15) + (it_ >= NGT ? 16384 : 0) + (c >> 3) * 512 + tid) : it_;
                const int ok = it & 31, dv = (it >> 5) & 511, dir = (it >> 14) & 1, bh = it >> 15, h = bh & 3;
                const float gch = ex2(256.0f * l2gam(dir ? 3 - h : h));
                bf16_t* pb = BT2 + ((size_t)(bh * 16) * 512 + dv) * 768 + 256 + dir * 256 + ok * 8;
                u32x4 v[16];
#pragma unroll
                for (int q = 0; q < 16; ++q) v[q] = *(const u32x4*)(pb + (size_t)q * 512 * 768);
                f32x4 s0 = (f32x4){0.f, 0.f, 0.f, 0.f}, s1 = s0;
                if (dir == 0) {
#pragma unroll
                    for (int q = 0; q < 16; ++q) { ST16((pb + (size_t)q * 512 * 768), pack8(s0, s1)); s0 = s0 * gch + unlo(v[q]); s1 = s1 * gch + unhi(v[q]); }
                } else {
#pragma unroll
                    for (int q = 15; q >= 0; --q) { ST16((pb + (size_t)q * 512 * 768), pack8(s0, s1)); s0 = s0 * gch + unlo(v[q]); s1 = s1 * gch + unhi(v[q]); }
                }
            }
        }
        PH_END;
        for (int rep_ = 0; rep_ < ((PH_ON && PHX(11)) ? NREP(11) : 0); ++rep_) {
            YSched S{(const char*)A2, (const char*)BT2, G, c}; EpiY E{YZ, YSS, SG, g}; pg8::gemm_phase(lds, 768, 768, 768, S, E);
        }
        PH_END;
    }
    for (int rep_ = 0; rep_ < (PH_ON ? 1 : 0); ++rep_) { PH_VARS
        float* RQ = (float*)(ws + WS_RQ);
        for (int tok = gt; tok < T; tok += NGT) { float rsv[4];
#pragma unroll
            for (int h = 0; h < 4; ++h) { const float* yq_ = YSS + (size_t)(tok * 4 + h) * 8; const f32x4 ya_ = *(const f32x4*)yq_ + *(const f32x4*)(yq_ + 4);
                rsv[h] = rsq(((ya_[0] + ya_[1]) + (ya_[2] + ya_[3])) * (1.0f / 512.0f) + EPS); }
            *(f32x4*)(RQ + (size_t)tok * 4) = (f32x4){rsv[0] / rsv[1], rsv[1] / rsv[2], rsv[2] / rsv[3], rsv[3]}; }
    }
    PH_END;
    for (int rep_ = 0; rep_ < ((PH_ON && PHX(13)) ? NREP(13) : 0); ++rep_) {
        StdSched S{(const char*)YZ, (const char*)WRO, 128, 4, 2048, 2048, G, c}; EpiRes<false, true> E{nullptr, XN, SS3, (const float*)(ws + WS_RQ)};
        pg8::gemm_phase(lds, 2048, 2048, 2048, S, E, pg8::HeadRescale{(const float*)(ws + WS_RQ)});
    }
    PH_END;
    for (int rep_ = 0; rep_ < ((PH_ON && PHX(14)) ? NREP(14) : 0); ++rep_) {
        FfnUpSched S{(const char*)XN, (const char*)(WFG + (size_t)FF * 1024), (const char*)(WFU + (size_t)FF * 1024), G, c}; EpiFfnUp E{SS3, ACT};
        pg8::gemm_phase(lds, 1024, 1024, 1024, S, E);
    }
    PH_END;
    for (int rep_ = 0; rep_ < ((PH_ON && PHX(15)) ? NREP(15) : 0); ++rep_) {
        StdSched S{(const char*)ACT, (const char*)(WFD + (size_t)FF * 1024), 128, 4, FF, FF, G, c}; EpiRes<false> E{nullptr, XN, SS4, nullptr};
        pg8::gemm_phase(lds, FF, FF, FF, S, E);
    }
    PH_END;
    for (int rep_ = 0; rep_ < ((PH_ON && PHX(16)) ? NREP(16) : 0); ++rep_) { PH_VARS
        for (int row = gw; row < T; row += 2 * NGW) { const int row2 = row + NGW < T ? row + NGW : row;
            const f32x4* sp = (const f32x4*)(SS4 + (size_t)row * 16); const f32x4* sp2 = (const f32x4*)(SS4 + (size_t)row2 * 16);
            const f32x4 a0 = sp[0], a1 = sp[1], a2_ = sp[2], a3 = sp[3], b0 = sp2[0], b1 = sp2[1], b2_ = sp2[2], b3 = sp2[3];
            const uint2* hrow = (const uint2*)(XN + (size_t)row * 1024) + lane; const uint2* hrow2 = (const uint2*)(XN + (size_t)row2 * 1024) + lane;
            uint2 hw[4], hw2[4];
#pragma unroll
            for (int j = 0; j < 4; ++j) { hw[j] = hrow[64 * j]; hw2[j] = hrow2[64 * j]; }
            const f32x4 sa = (a0 + a1) + (a2_ + a3), sb = (b0 + b1) + (b2_ + b3);
            const float rs = rsq(((sa[0] + sa[1]) + (sa[2] + sa[3])) * (1.0f / 1024.0f) + EPS), rs2 = rsq(((sb[0] + sb[1]) + (sb[2] + sb[3])) * (1.0f / 1024.0f) + EPS);
            f32x4* orow = (f32x4*)(out + (size_t)row * 1024) + lane; f32x4* orow2 = (f32x4*)(out + (size_t)row2 * 1024) + lane;
#pragma unroll
            for (int j = 0; j < 4; ++j) { const f32x4 gv = ((const f32x4*)ln_fin)[64 * j + lane];
                f32x4 hv; hv[0] = __uint_as_float(hw[j].x << 16); hv[1] = __uint_as_float(hw[j].x & 0xffff0000u); hv[2] = __uint_as_float(hw[j].y << 16); hv[3] = __uint_as_float(hw[j].y & 0xffff0000u);
                orow[64 * j] = hv * rs * gv;
                if (row2 != row) { f32x4 hv2; hv2[0] = __uint_as_float(hw2[j].x << 16); hv2[1] = __uint_as_float(hw2[j].x & 0xffff0000u); hv2[2] = __uint_as_float(hw2[j].y << 16); hv2[3] = __uint_as_float(hw2[j].y & 0xffff0000u);
                    orow2[64 * j] = hv2 * rs2 * gv; } } }
    }
    PH_FINAL;
}
constexpr int N_PHASES = 8 + 5 * NGRP + 1 + 4;

extern "C" void kernel_launch(void* const* d_in, const int* in_sizes, int n_in, void* d_out, int out_size, void* d_ws, size_t ws_size, hipStream_t stream) {
    static int grid = 0;
    if (grid == 0) {
        if (n_in != 18 || out_size != T * D || ws_size < WS_END) { fprintf(stderr, "kernel_launch: unexpected shapes (n_in %d out %d ws %zu)\n", n_in, out_size, ws_size); grid = -1; return; }
        int dev = 0, cus = 0, per_cu = 0;
        hipGetDevice(&dev); hipDeviceGetAttribute(&cus, hipDeviceAttributeMultiprocessorCount, dev);
        hipFuncSetAttribute((const void*)mk_fwd, hipFuncAttributeMaxDynamicSharedMemorySize, LDS_BYTES);
        hipOccupancyMaxActiveBlocksPerMultiprocessor(&per_cu, (const void*)mk_fwd, 512, LDS_BYTES);
        if (per_cu < 1) { fprintf(stderr, "kernel_launch: occupancy query says %d blocks/CU\n", per_cu); grid = -1; return; }
        grid = cus;
        (void)hipGetLastError();
    }
    if (grid < 0) return;
    Args a{};
    for (int i = 0; i < 18; ++i) a.in[i] = (const float*)d_in[i];
    a.out = (float*)d_out; a.ws = (unsigned char*)d_ws; a.ph_lo = 0; a.ph_hi = N_PHASES;
    void* kargs[] = {&a};
#ifdef DBG
    for (int ph = 0; ph < N_PHASES; ++ph) { a.ph_lo = ph; a.ph_hi = ph + 1;
        hipError_t e = hipLaunchCooperativeKernel((const void*)mk_fwd, dim3(grid), dim3(512), kargs, LDS_BYTES, stream);
        if (e != hipSuccess) fprintf(stderr, "cooperative launch failed: %s (grid %d)\n", hipGetErrorString(e), grid);
        hipLaunchKernelGGL(dbg_kernel, dim3(1), dim3(512), 0, stream, a, ph); }
    hipLaunchKernelGGL(dbg_emit, dim3(1024), dim3(512), 0, stream, a);
#else
    (void)hipMemsetAsync((unsigned char*)d_ws + WS_BAR, 0, XCD_BAR_WORDS * 4, stream);
    hipError_t e = hipLaunchCooperativeKernel((const void*)mk_fwd, dim3(grid), dim3(512), kargs, LDS_BYTES, stream);
    if (e != hipSuccess) fprintf(stderr, "cooperative launch failed: %s (grid %d)\n", hipGetErrorString(e), grid);
#endif
}
```

```cpp
#include <hip/hip_runtime.h>
#include <hip/hip_cooperative_groups.h>
#include <cstdio>
#include <cstdint>
namespace cg = cooperative_groups;

#define LAS __attribute__((address_space(3)))
typedef unsigned short bf16_t;
typedef short bf16x8 __attribute__((ext_vector_type(8)));
typedef float f32x4 __attribute__((ext_vector_type(4)));
typedef unsigned u32x4 __attribute__((ext_vector_type(4)));
typedef _Float16 half2_t __attribute__((ext_vector_type(2)));

constexpr int T = 32768, D = 1024, SEQ = 4096, FF = 2816, NGRP = 4, TG = 8192;
constexpr float EPS = 1e-6f;
constexpr size_t MiB = 1u << 20;
constexpr size_t WS_SS1 = 484 * MiB, WS_SS2 = 486 * MiB, WS_SS3 = 488 * MiB, WS_SS4 = 490 * MiB, WS_YSS = 492 * MiB;
constexpr size_t WS_RQ = 0;
constexpr size_t WS_COST = 1 * MiB, WS_SINT = 3 * MiB, WS_COSJ = 5 * MiB, WS_SINJ = 7 * MiB, WS_CLA = 9 * MiB;
constexpr size_t WS_WIN = 10 * MiB, WS_WGA = 14 * MiB, WS_WGX = 15 * MiB, WS_WLO = 16 * MiB, WS_WFG = 18 * MiB, WS_WFU = 29 * MiB,
                 WS_WFD = 40 * MiB, WS_WRI = 51 * MiB, WS_WRO = 63 * MiB;
constexpr size_t WS_XN = 68 * MiB;
constexpr size_t WS_XBP = 132 * MiB, WS_GG = 196 * MiB, WS_XB = 260 * MiB, WS_LAF = 68 * MiB, WS_INF = 132 * MiB, WS_LAB = 324 * MiB,
                 WS_INB = 388 * MiB, WS_YL = 260 * MiB;
constexpr size_t WS_ACT = 132 * MiB;
constexpr size_t WS_YZ = 132 * MiB, WS_A2 = 260 * MiB, WS_KB = 308 * MiB, WS_KTF = 324 * MiB, WS_KTB = 340 * MiB, WS_BT2 = 356 * MiB,
                 WS_SG = 452 * MiB, WS_END = 496 * MiB;
constexpr int LDS_BYTES = 147456;

__device__ __forceinline__ float l2gam(int h) {
    return h == 0 ? -0.04580368961312479f : (h == 1 ? -0.02272007650008353f : (h == 2 ? -0.011315313227834146f : -0.005646563141142063f));
}
__device__ __forceinline__ float ex2(float x) { return __builtin_amdgcn_exp2f(x); }
__device__ __forceinline__ float rcpf_(float x) { return __builtin_amdgcn_rcpf(x); }
__device__ __forceinline__ float sigm(float x) { return rcpf_(1.0f + ex2(-1.4426950408889634f * x)); }
__device__ __forceinline__ float rsq(float x) { return __builtin_amdgcn_rsqf(x); }
__device__ __forceinline__ unsigned cvt_pk_bf16(float lo, float hi) { unsigned r; asm volatile("v_cvt_pk_bf16_f32 %0, %1, %2" : "=v"(r) : "v"(lo), "v"(hi)); return r; }
__device__ __forceinline__ u32x4 pack8(f32x4 a, f32x4 b) { u32x4 w; w.x = cvt_pk_bf16(a[0], a[1]); w.y = cvt_pk_bf16(a[2], a[3]); w.z = cvt_pk_bf16(b[0], b[1]); w.w = cvt_pk_bf16(b[2], b[3]); return w; }
__device__ __forceinline__ f32x4 unlo(u32x4 w) { f32x4 r; r[0] = __uint_as_float(w.x << 16); r[1] = __uint_as_float(w.x & 0xffff0000u); r[2] = __uint_as_float(w.y << 16); r[3] = __uint_as_float(w.y & 0xffff0000u); return r; }
__device__ __forceinline__ f32x4 unhi(u32x4 w) { f32x4 r; r[0] = __uint_as_float(w.z << 16); r[1] = __uint_as_float(w.z & 0xffff0000u); r[2] = __uint_as_float(w.w << 16); r[3] = __uint_as_float(w.w & 0xffff0000u); return r; }
__device__ __forceinline__ unsigned pkh(float lo, float hi) { half2_t h; h.x = (_Float16)lo; h.y = (_Float16)hi; return __builtin_bit_cast(unsigned, h); }
__device__ __forceinline__ u32x4 pack8h(f32x4 a, f32x4 b) { u32x4 w; w.x = pkh(a[0], a[1]); w.y = pkh(a[2], a[3]); w.z = pkh(b[0], b[1]); w.w = pkh(b[2], b[3]); return w; }
__device__ __forceinline__ float h2f_lo(unsigned w) { return (float)__builtin_bit_cast(_Float16, (unsigned short)(w & 0xffffu)); }
__device__ __forceinline__ float h2f_hi(unsigned w) { return (float)__builtin_bit_cast(_Float16, (unsigned short)(w >> 16)); }
__device__ __forceinline__ f32x4 unlo_h(u32x4 w) { const unsigned a = w.x, b = w.y; f32x4 r; r[0] = h2f_lo(a); r[1] = h2f_hi(a); r[2] = h2f_lo(b); r[3] = h2f_hi(b); return r; }
__device__ __forceinline__ f32x4 unhi_h(u32x4 w) { const unsigned a = w.z, b = w.w; f32x4 r; r[0] = h2f_lo(a); r[1] = h2f_hi(a); r[2] = h2f_lo(b); r[3] = h2f_hi(b); return r; }
__device__ __forceinline__ f32x4 ex2v(f32x4 v) { f32x4 r; r[0] = ex2(v[0]); r[1] = ex2(v[1]); r[2] = ex2(v[2]); r[3] = ex2(v[3]); return r; }
__device__ __forceinline__ f32x4 sigv(f32x4 v) { f32x4 r; r[0] = sigm(v[0]); r[1] = sigm(v[1]); r[2] = sigm(v[2]); r[3] = sigm(v[3]); return r; }
__device__ __forceinline__ f32x4 geluv(f32x4 x) {
    f32x4 r;
#pragma unroll
    for (int i = 0; i < 4; ++i) { const float v = x[i], u = 0.7978845608028654f * (v + 0.044715f * v * v * v); r[i] = v * rcpf_(1.0f + ex2(-2.8853900817779268f * u)); }
    return r;
}

__device__ __forceinline__ void lru_step(float l, float q, float& H) { const float a = ex2(l); H = a * H + __builtin_amdgcn_sqrtf(fmaxf(1.0f - a * a, 0.f)) * q; }
__device__ __forceinline__ float sum16(const float* p) { const f32x4 a = *(const f32x4*)p, b = *(const f32x4*)(p + 4), c = *(const f32x4*)(p + 8), d = *(const f32x4*)(p + 12);
    const f32x4 s = (a + b) + (c + d); return (s[0] + s[1]) + (s[2] + s[3]); }
__device__ __forceinline__ float row_rs(const float* ssp, int row) { return rsq(sum16(ssp + (size_t)row * 16) * (1.0f / 1024.0f) + EPS); }
namespace pg8 {
constexpr int BM = 256, BK = 64, HALF = 128, HTB = HALF * BK * 2, STAGE_BYTES = 8 * HTB;
__device__ __forceinline__ int lds_byte(int r, int c) { const int st = (r >> 4) * 2 + (c >> 5), rr = r & 15, cc = c & 31, ob = rr * 64 + cc * 2; return st * 1024 + (ob ^ (((ob >> 9) & 1) << 5)); }
__device__ __forceinline__ void stage_rc(int b, int& R, int& C) { const int st = b / 1024, sb = b % 1024, swz = sb ^ (((sb >> 9) & 1) << 5); R = (st >> 1) * 16 + swz / 64; C = (st & 1) * 32 + (swz % 64) / 2; }
__device__ __forceinline__ int perm32(int rho) { const int n = rho >> 4, i = rho & 15; return 8 * (i >> 2) + 4 * n + (i & 3); }
struct Unit { const char *a0, *a1, *b0, *b1; int pm, pn, z; };

struct NoHook { static constexpr bool ON = false; };
struct HeadRescale { static constexpr bool ON = true; const float* rq; };
template <class Epi, class Sched, class Hook = NoHook>
__device__ __forceinline__ void gemm_phase(LAS unsigned char* lds, const int lda, const int ldb, const int K, const Sched& S, const Epi& E, const Hook HK = Hook()) {
    int tid = threadIdx.x; asm volatile("" : "+v"(tid));
    const int wid = __builtin_amdgcn_readfirstlane(tid >> 6), lane = tid & 63, wr = wid >> 2, wc = wid & 3, fr = lane & 15, fq = lane >> 4;
    const int nt = K / BK;
    unsigned voffA[2], voffB[2];
#pragma unroll
    for (int i = 0; i < 2; ++i) { int R, C; stage_rc(tid * 16 + i * 8192, R, C); const int Rb = (R & ~31) + perm32(R & 31);
        voffA[i] = (unsigned)(R * lda + C) * 2u; voffB[i] = (unsigned)(Rb * ldb + C) * 2u; }
    const size_t kstep = (size_t)(BK * 2);
    const unsigned ldsw = (unsigned)wid * 1024u;
    const int aoff = lds_byte(wr * 64 + fr, fq * 8), boff = lds_byte(wc * 32 + fr, fq * 8);
#define PG8_SA(b, h) (((b) * 2 + (h)) * HTB)
#define PG8_SB(b, h) ((4 + (b) * 2 + (h)) * HTB)
#define PG8_STAGE(bufoff, gbase, voff) do { _Pragma("unroll") for (int _i = 0; _i < 2; ++_i) \
        __builtin_amdgcn_global_load_lds((const unsigned*)((const char*)(gbase) + (voff)[_i]), (LAS unsigned*)(lds + (bufoff) + ldsw + _i * 8192), 16, 0, 0); } while (0)
#define PG8_LDA(dst, b, h) do { _Pragma("unroll") for (int m = 0; m < 4; ++m) _Pragma("unroll") for (int k = 0; k < 2; ++k) dst[m][k] = *(const LAS bf16x8*)(lds + PG8_SA(b, h) + aoff + m * 2048 + k * 1024); } while (0)
#define PG8_LDB(dst, b, h) do { _Pragma("unroll") for (int n = 0; n < 2; ++n) _Pragma("unroll") for (int k = 0; k < 2; ++k) dst[n][k] = *(const LAS bf16x8*)(lds + PG8_SB(b, h) + boff + n * 2048 + k * 1024); } while (0)
#define PG8_MMA(ai, bj, At, Bt) do { __builtin_amdgcn_s_setprio(1); _Pragma("unroll") for (int m = 0; m < 4; ++m) _Pragma("unroll") for (int n = 0; n < 2; ++n) _Pragma("unroll") for (int k = 0; k < 2; ++k) \
        acc[ai][bj][m][n] = __builtin_amdgcn_mfma_f32_16x16x32_bf16(Bt[n][k], At[m][k], acc[ai][bj][m][n], 0, 0, 0); __builtin_amdgcn_s_setprio(0); } while (0)
#define PG8_WAIT_V(n) asm volatile("s_waitcnt vmcnt(" #n ")" ::: "memory")
#define PG8_WAIT_L(n) asm volatile("s_waitcnt lgkmcnt(" #n ")" ::: "memory")
#define PG8_BAR __builtin_amdgcn_s_barrier()
#define PG8_SCHED __builtin_amdgcn_sched_barrier(0)
    Unit cur, nxt; int ui = 0;
    if (!S.next(0, cur)) return;
#define PG8_OPAQUE(u) asm volatile("" : "+s"((u).a0), "+s"((u).a1), "+s"((u).b0), "+s"((u).b1))
    PG8_OPAQUE(cur);
    f32x4 acc[2][2][4][2];
#pragma unroll
    for (int a = 0; a < 2; ++a)
#pragma unroll
        for (int b = 0; b < 2; ++b)
#pragma unroll
            for (int m = 0; m < 4; ++m)
#pragma unroll
                for (int n = 0; n < 2; ++n) acc[a][b][m][n] = (f32x4){0.f, 0.f, 0.f, 0.f};
    bf16x8 At[4][2], B0[2][2], B1[2][2];
    float hkr[8] = {1.f, 1.f, 1.f, 1.f, 1.f, 1.f, 1.f, 1.f}; (void)hkr;
    const char *cA0 = cur.a0, *cA1 = cur.a1, *cB0 = cur.b0, *cB1 = cur.b1;
    PG8_STAGE(PG8_SB(0, 0), cB0, voffB); PG8_STAGE(PG8_SB(0, 1), cB1, voffB); PG8_STAGE(PG8_SA(0, 0), cA0, voffA); PG8_STAGE(PG8_SA(0, 1), cA1, voffA);
    if (wr == 1) PG8_BAR;
    PG8_WAIT_V(2); PG8_BAR;
    PG8_STAGE(PG8_SB(1, 0), cB0 + kstep, voffB); PG8_STAGE(PG8_SA(1, 0), cA0 + kstep, voffA); PG8_STAGE(PG8_SB(1, 1), cB1 + kstep, voffB);
    PG8_WAIT_V(6); PG8_BAR;
    for (;;) {
        const bool has_next = S.next(ui + 1, nxt);
        if (has_next) PG8_OPAQUE(nxt);
        const char *nA0 = has_next ? nxt.a0 : cA0, *nA1 = has_next ? nxt.a1 : cA1, *nB0 = has_next ? nxt.b0 : cB0, *nB1 = has_next ? nxt.b1 : cB1;
#pragma unroll 1
        for (int t = 0; t < nt; t += 2) {
            const bool last = (t == nt - 2);
            bool hk = false;
            if constexpr (Hook::ON) { hk = (((t + 2) & 7) == 0) && (t + 2 < nt);
                if (hk) { const int hd = ((t + 2) >> 3) - 1;
                    int frh = fr; asm volatile("" : "+v"(frh));
#pragma unroll
                    for (int ai = 0; ai < 2; ++ai)
#pragma unroll
                        for (int m = 0; m < 4; ++m) hkr[ai * 4 + m] = HK.rq[(size_t)(cur.pm * 256 + ai * 128 + wr * 64 + m * 16 + frh) * 4 + hd]; } }
            const char* a1_1 = cA1 + (size_t)(t + 1) * kstep;
            const char* a2_0 = last ? nA0 : cA0 + (size_t)(t + 2) * kstep; const char* a2_1 = last ? nA1 : cA1 + (size_t)(t + 2) * kstep;
            const char* b2_0 = last ? nB0 : cB0 + (size_t)(t + 2) * kstep; const char* b2_1 = last ? nB1 : cB1 + (size_t)(t + 2) * kstep;
            const char* a3_0 = a2_0 + kstep; const char* b3_0 = b2_0 + kstep; const char* b3_1 = b2_1 + kstep;
            PG8_LDB(B0, 0, 0); PG8_LDB(B1, 0, 1); PG8_SCHED; PG8_LDA(At, 0, 0); PG8_STAGE(PG8_SA(1, 1), a1_1, voffA);
            PG8_WAIT_V(8); PG8_WAIT_L(0); PG8_BAR; PG8_MMA(0, 0, At, B0); PG8_MMA(0, 1, At, B1); PG8_BAR; PG8_SCHED;
            PG8_LDA(At, 0, 1); PG8_STAGE(PG8_SB(0, 0), b2_0, voffB); PG8_STAGE(PG8_SB(0, 1), b2_1, voffB); PG8_STAGE(PG8_SA(0, 0), a2_0, voffA);
            PG8_WAIT_V(8); PG8_WAIT_L(0); PG8_BAR; PG8_MMA(1, 0, At, B0); PG8_MMA(1, 1, At, B1); PG8_BAR; PG8_SCHED;
            PG8_LDB(B0, 1, 0); PG8_LDB(B1, 1, 1); PG8_SCHED; PG8_LDA(At, 1, 0); PG8_STAGE(PG8_SA(0, 1), a2_1, voffA);
            PG8_WAIT_V(8); PG8_WAIT_L(0); PG8_BAR; PG8_MMA(0, 0, At, B0); PG8_MMA(0, 1, At, B1); PG8_BAR; PG8_SCHED;
            PG8_LDA(At, 1, 1); PG8_STAGE(PG8_SB(1, 0), b3_0, voffB); PG8_STAGE(PG8_SB(1, 1), b3_1, voffB); PG8_STAGE(PG8_SA(1, 0), a3_0, voffA);
            PG8_WAIT_V(8); PG8_WAIT_L(0); PG8_BAR; PG8_MMA(1, 0, At, B0); PG8_MMA(1, 1, At, B1); PG8_BAR; PG8_SCHED;
            if constexpr (Hook::ON) { if (hk) {
#pragma unroll
                for (int ai = 0; ai < 2; ++ai)
#pragma unroll
                    for (int bj = 0; bj < 2; ++bj)
#pragma unroll
                        for (int m = 0; m < 4; ++m)
#pragma unroll
                            for (int n = 0; n < 2; ++n) acc[ai][bj][m][n] = acc[ai][bj][m][n] * hkr[ai * 4 + m]; } }
        }
        if (wr == 0) PG8_BAR;
        { int fr_ = fr, fq_ = fq; asm volatile("" : "+v"(fr_), "+v"(fq_)); E(acc, cur, wr, wc, fr_, fq_); }
        if (!has_next) break;
#pragma unroll
        for (int a = 0; a < 2; ++a)
#pragma unroll
            for (int b = 0; b < 2; ++b)
#pragma unroll
                for (int m = 0; m < 4; ++m)
#pragma unroll
                    for (int n = 0; n < 2; ++n) acc[a][b][m][n] = (f32x4){0.f, 0.f, 0.f, 0.f};
        cur = nxt; cA0 = nA0; cA1 = nA1; cB0 = nB0; cB1 = nB1; ++ui;
        if (wr == 1) PG8_BAR;
    }
    PG8_WAIT_V(0);
    PG8_BAR;
#undef PG8_OPAQUE
#undef PG8_SA
#undef PG8_SB
#undef PG8_STAGE
#undef PG8_LDA
#undef PG8_LDB
#undef PG8_MMA
#undef PG8_WAIT_V
#undef PG8_WAIT_L
#undef PG8_BAR
#undef PG8_SCHED
}
}
using pg8::Unit;
typedef const f32x4 (&AccRef)[2][2][4][2];

__device__ __forceinline__ bool order2d(int i, int G, int c, int nM, int nN, int& pm, int& pn) {
    const int nwg = nM * nN; const long L = (long)i * G + c; if (L >= nwg) return false;
    int wgid = (int)L; { const int q = nwg / 8, r = nwg % 8, xcd = wgid % 8, off = wgid / 8; wgid = (xcd < r ? xcd * (q + 1) : r * (q + 1) + (xcd - r) * q) + off; }
    const int nig = 8 * nN, gid = wgid / nig, fm = gid * 8, gsz = (nM - fm) < 8 ? (nM - fm) : 8;
    pm = fm + ((wgid % nig) % gsz); pn = (wgid % nig) / gsz; return true;
}
struct StdSched {
    const char *A, *B; int nM, nN, lda, ldb, G, c;
    __device__ __forceinline__ bool next(int i, Unit& u) const {
        int pm, pn; if (!order2d(i, G, c, nM, nN, pm, pn)) return false;
        u.pm = pm; u.pn = pn; u.z = 0; u.a0 = A + (size_t)pm * 256 * lda * 2; u.a1 = u.a0 + (size_t)128 * lda * 2; u.b0 = B + (size_t)pn * 256 * ldb * 2; u.b1 = u.b0 + (size_t)128 * ldb * 2; return true; }
};
struct GateSched {
    const char *XB, *WGA, *WGX; int G, c;
    __device__ __forceinline__ bool next(int i, Unit& u) const {
        int pm, pn; if (!order2d(i, G, c, 128, 16, pm, pn)) return false;
        const int z = pn >> 2, d = (pn >> 1) & 1, hf = pn & 1; u.pm = pm; u.pn = pn; u.z = 0;
        u.a0 = XB + ((size_t)pm * 256 * 1024 + z * 256) * 2; u.a1 = u.a0 + (size_t)128 * 1024 * 2;
        const size_t bo = (size_t)(((d * 4 + z) * 256 + hf * 128) * 256) * 2; u.b0 = WGA + bo; u.b1 = WGX + bo; return true; }
};
struct FfnUpSched {
    const char *A, *WG, *WU; int G, c;
    __device__ __forceinline__ bool next(int i, Unit& u) const {
        int pm, pn; if (!order2d(i, G, c, 128, 22, pm, pn)) return false;
        u.pm = pm; u.pn = pn; u.z = 0; u.a0 = A + (size_t)pm * 256 * 1024 * 2; u.a1 = u.a0 + (size_t)128 * 1024 * 2;
        u.b0 = WG + (size_t)pn * 128 * 1024 * 2; u.b1 = WU + (size_t)pn * 128 * 1024 * 2; return true; }
};
struct ScoreSched {
    const char *A2, *KB; int G, c;
    __device__ __forceinline__ bool next(int i, Unit& u) const {
        const int L = i * G + c; if (L >= 128) return false;
        const int z = L, bl = z >> 6, h = (z >> 4) & 3, cc = z & 15; u.pm = 0; u.pn = 0; u.z = z;
        u.a0 = A2 + ((size_t)z * 256 * 768 + 256) * 2; u.a1 = u.a0 + (size_t)128 * 768 * 2;
        u.b0 = KB + (((size_t)bl * 4096 + cc * 256) * 1024 + h * 256) * 2; u.b1 = u.b0 + (size_t)128 * 1024 * 2; return true; }
};
struct KvSched {
    const char *BT2, *KTF, *KTB; int G, c;
    __device__ __forceinline__ bool next(int i, Unit& u) const {
        const int L = i * G + c; if (L >= 512) return false;
        const int xq = L & 7, sq_ = L >> 3;
        const int z = xq * 16 + (sq_ >> 2), dir = (sq_ >> 1) & 1, dvh = sq_ & 1, bl = z >> 6, h = (z >> 4) & 3, cc = z & 15; u.pm = dvh; u.pn = dir; u.z = z;
        u.a0 = BT2 + ((size_t)(z * 512 + dvh * 256) * 768) * 2; u.a1 = u.a0 + (size_t)128 * 768 * 2;
        u.b0 = (dir ? KTB : KTF) + ((size_t)(h * 256) * TG + bl * 4096 + cc * 256) * 2; u.b1 = u.b0 + (size_t)128 * TG * 2; return true; }
};
struct YSched {
    const char *A2, *BT2; int G, c;
    __device__ __forceinline__ bool next(int i, Unit& u) const {
        const int L = i * G + c; if (L >= 256) return false;
        const int xq = L & 7, sq_ = L >> 3; const int z = xq * 16 + (sq_ >> 1), dvh = sq_ & 1; u.pm = 0; u.pn = dvh; u.z = z;
        u.a0 = A2 + (size_t)z * 256 * 768 * 2; u.a1 = u.a0 + (size_t)128 * 768 * 2;
        u.b0 = BT2 + ((size_t)(z * 512 + dvh * 256) * 768) * 2; u.b1 = u.b0 + (size_t)128 * 768 * 2; return true; }
};

__device__ __forceinline__ void rows_rs8(const float* ssp, int row0, int fq, float (&rsv)[8]) {
    f32x4 p[8];
#pragma unroll
    for (int i = 0; i < 8; ++i) p[i] = *(const f32x4*)(ssp + (size_t)(row0 + (i >> 2) * 128 + (i & 3) * 16) * 16 + fq * 4);
#pragma unroll
    for (int i = 0; i < 8; ++i) { float s_ = (p[i][0] + p[i][1]) + (p[i][2] + p[i][3]); s_ += __shfl_xor(s_, 16); s_ += __shfl_xor(s_, 32); rsv[i] = rsq(s_ * (1.0f / 1024.0f) + EPS); }
}
__device__ __forceinline__ void rows_rs4(const float* ssp, int row0, int fq, float (&rsv)[4]) {
    f32x4 p[4];
#pragma unroll
    for (int i = 0; i < 4; ++i) p[i] = *(const f32x4*)(ssp + (size_t)(row0 + i * 16) * 16 + fq * 4);
#pragma unroll
    for (int i = 0; i < 4; ++i) { float s_ = (p[i][0] + p[i][1]) + (p[i][2] + p[i][3]); s_ += __shfl_xor(s_, 16); s_ += __shfl_xor(s_, 32); rsv[i] = rsq(s_ * (1.0f / 1024.0f) + EPS); }
}
#ifndef ST_SC1
#define ST_SC1 0
#endif
#if ST_SC1
#define ST16(p, v) do { const u32x4 v_ = (v); const void* p_ = (const void*)(p); asm volatile("global_store_dwordx4 %0, %1, off sc1" :: "v"(p_), "v"(v_) : "memory"); } while (0)
#else
#define ST16(p, v) do { *(u32x4*)(p) = (v); } while (0)
#endif
#define EPI_ARGS AccRef acc, const Unit& u, int wr, int wc, int fr, int fq
__device__ __forceinline__ bool epi_fence() { asm volatile("" ::: "memory"); __builtin_amdgcn_sched_barrier(0); return true; }
#define FOR_AI_M _Pragma("unroll") for (int ai = 0; ai < 2; ++ai) _Pragma("unroll") for (int m = 0; m < 4; ++m) if (epi_fence())

struct EpiP1 {
    bf16_t* xbp; bf16_t* gg;
    __device__ __forceinline__ void operator()(EPI_ARGS) const {
        const int row0 = u.pm * 256 + wr * 64 + fr;
        if (u.pn < 4) {
            FOR_AI_M { bf16_t* rp = xbp + (size_t)(row0 + ai * 128 + m * 16) * 1024 + u.pn * 256 + wc * 32 + fq * 8;
#pragma unroll
                for (int bj = 0; bj < 2; ++bj) ST16((rp + bj * 128), pack8(acc[ai][bj][m][0], acc[ai][bj][m][1])); }
        } else {
            const int b = u.pm >> 4;
            FOR_AI_M { const int t = (row0 + ai * 128 + m * 16) & 4095;
#pragma unroll
                for (int bj = 0; bj < 2; ++bj) { const int cgp = (u.pn - 4) * 8 + bj * 4 + wc;
                    bf16_t* p = gg + ((size_t)((b * 32 + cgp) * 4096 + t)) * 32 + fq * 8;
                    ST16(p, pack8(geluv(acc[ai][bj][m][0]), geluv(acc[ai][bj][m][1]))); } }
        }
    }
};
struct EpiGate {
    const bf16_t* xb; const float *ga_b, *gx_b, *cla; unsigned short* laf; bf16_t* inf; unsigned short* lab; bf16_t* inb;
    __device__ __forceinline__ void operator()(EPI_ARGS) const {
        const int z = u.pn >> 2, d = (u.pn >> 1) & 1, hf = u.pn & 1;
        const int ch0 = z * 256 + hf * 128 + wc * 32 + fq * 8;
        const f32x4 ba0 = *(const f32x4*)(ga_b + d * 1024 + ch0), ba1 = *(const f32x4*)(ga_b + d * 1024 + ch0 + 4);
        const f32x4 bx0 = *(const f32x4*)(gx_b + d * 1024 + ch0), bx1 = *(const f32x4*)(gx_b + d * 1024 + ch0 + 4);
        const f32x4 cl0 = *(const f32x4*)(cla + d * 1024 + ch0), cl1 = *(const f32x4*)(cla + d * 1024 + ch0 + 4);
        const int b = u.pm >> 4, cgp = z * 8 + hf * 4 + wc;
        unsigned short* lap = d ? lab : laf; bf16_t* inp = d ? inb : inf;
        u32x4 xw8[8];
#pragma unroll
        for (int i = 0; i < 8; ++i) xw8[i] = *(const u32x4*)(xb + (size_t)(u.pm * 256 + (i >> 2) * 128 + wr * 64 + (i & 3) * 16 + fr) * 1024 + ch0);
        FOR_AI_M { const int row = u.pm * 256 + ai * 128 + wr * 64 + m * 16 + fr, t = row & 4095;
            const u32x4 xw = xw8[ai * 4 + m];
            const f32x4 x0 = unlo(xw), x1 = unhi(xw);
            const f32x4 r0 = sigv(acc[ai][0][m][0] + ba0), r1 = sigv(acc[ai][0][m][1] + ba1);
            const f32x4 i0 = sigv(acc[ai][1][m][0] + bx0), i1 = sigv(acc[ai][1][m][1] + bx1);
            const f32x4 l0 = r0 * cl0, l1 = r1 * cl1;
            const f32x4 q0 = i0 * x0, q1 = i1 * x1;
            const size_t off = ((size_t)((b * 32 + cgp) * 4096 + t)) * 32 + fq * 8;
            ST16((lap + off), pack8h(l0, l1));
            ST16((inp + off), pack8(q0, q1)); }
    }
};
template <bool BASE_F32, bool SCALED = false> struct EpiRes {
    const float* basef; bf16_t* xn; float* ss; const float* rq;
    __device__ __forceinline__ void operator()(EPI_ARGS) const {
        constexpr bool PIPE = BASE_F32 || SCALED;
        u32x4 bw16[16]; f32x4 fb[2][4]; u32x4 bb[2][2]; float scb[2] = {1.f, 1.f};
        const size_t off00 = (size_t)(u.pm * 256 + wr * 64 + fr) * 1024 + u.pn * 256 + wc * 32 + fq * 8;
        if constexpr (!PIPE) {
#pragma unroll
            for (int i = 0; i < 16; ++i) bw16[i] = *(const u32x4*)(xn + off00 + (size_t)((i >> 3) * 128 + ((i >> 1) & 3) * 16) * 1024 + (i & 1) * 128);
        } else if constexpr (BASE_F32) {
#pragma unroll
            for (int q = 0; q < 4; ++q) fb[0][q] = *(const f32x4*)(basef + off00 + (q >> 1) * 128 + (q & 1) * 4);
        } else {
            bb[0][0] = *(const u32x4*)(xn + off00); bb[0][1] = *(const u32x4*)(xn + off00 + 128); scb[0] = rq[(size_t)(u.pm * 256 + wr * 64 + fr) * 4 + 3];
        }
        FOR_AI_M { const int row = u.pm * 256 + ai * 128 + wr * 64 + m * 16 + fr; float sq = 0.f; const int k = ai * 4 + m;
            if constexpr (PIPE) { if (k < 7) { const int k1 = k + 1; const size_t o1 = off00 + (size_t)((k1 >> 2) * 128 + (k1 & 3) * 16) * 1024;
                if constexpr (BASE_F32) {
#pragma unroll
                    for (int q = 0; q < 4; ++q) fb[k1 & 1][q] = *(const f32x4*)(basef + o1 + (q >> 1) * 128 + (q & 1) * 4);
                } else { bb[k1 & 1][0] = *(const u32x4*)(xn + o1); bb[k1 & 1][1] = *(const u32x4*)(xn + o1 + 128);
                    scb[k1 & 1] = rq[(size_t)(u.pm * 256 + (k1 >> 2) * 128 + wr * 64 + (k1 & 3) * 16 + fr) * 4 + 3]; } } }
            const float sc = SCALED ? scb[k & 1] : 1.0f;
#pragma unroll
            for (int bj = 0; bj < 2; ++bj) { const size_t off = (size_t)row * 1024 + u.pn * 256 + bj * 128 + wc * 32 + fq * 8;
                f32x4 h0, h1;
                if constexpr (BASE_F32) { h0 = fb[k & 1][bj * 2] + acc[ai][bj][m][0]; h1 = fb[k & 1][bj * 2 + 1] + acc[ai][bj][m][1]; }
                else { const u32x4 bw = SCALED ? bb[k & 1][bj] : bw16[k * 2 + bj]; h0 = unlo(bw) + acc[ai][bj][m][0] * sc; h1 = unhi(bw) + acc[ai][bj][m][1] * sc; }
                ST16((xn + off), pack8(h0, h1));
                sq += (h0[0] * h0[0] + h0[1] * h0[1]) + (h0[2] * h0[2] + h0[3] * h0[3]) + (h1[0] * h1[0] + h1[1] * h1[1]) + (h1[2] * h1[2] + h1[3] * h1[3]); }
            sq += __shfl_xor(sq, 16); sq += __shfl_xor(sq, 32);
            if (fq == 0) ss[(size_t)row * 16 + u.pn * 4 + wc] = sq; }
    }
};
struct EpiFfnUp {
    const float* ss; bf16_t* act;
    __device__ __forceinline__ void operator()(EPI_ARGS) const {
        float rsv[8]; rows_rs8(ss, u.pm * 256 + wr * 64 + fr, fq, rsv);
        FOR_AI_M { const int row = u.pm * 256 + ai * 128 + wr * 64 + m * 16 + fr; const float rs = rsv[ai * 4 + m];
            const f32x4 g0 = acc[ai][0][m][0] * rs, g1 = acc[ai][0][m][1] * rs, u0 = acc[ai][1][m][0] * rs, u1 = acc[ai][1][m][1] * rs;
            ST16((act + (size_t)row * FF + u.pn * 128 + wc * 32 + fq * 8), pack8(g0 * sigv(g0) * u0, g1 * sigv(g1) * u1)); }
    }
};
struct EpiRetA {
    const float* ss; const float *cost, *sint; bf16_t *a2, *sg, *kb; int g;
    __device__ __forceinline__ void operator()(EPI_ARGS) const {
        const int bl = u.pm >> 4, cc = u.pm & 15;
        if (u.pn >= 4 && u.pn < 12) {
#pragma unroll
            for (int ai = 0; ai < 2; ++ai) { float rs4[4]; rows_rs4(ss, g * TG + u.pm * 256 + ai * 128 + wr * 64 + fr, fq, rs4);
#pragma unroll
                for (int m = 0; m < 4; ++m) if (epi_fence()) { const int r = ai * 128 + wr * 64 + m * 16 + fr, rowg = u.pm * 256 + r; const float rs = rs4[m];
#pragma unroll
                    for (int bj = 0; bj < 2; ++bj) { const f32x4 v0 = acc[ai][bj][m][0] * rs, v1 = acc[ai][bj][m][1] * rs;
                        ST16((sg + (size_t)rowg * 2048 + (u.pn - 4) * 256 + bj * 128 + wc * 32 + fq * 8), pack8(v0 * sigv(v0), v1 * sigv(v1))); } } }
        } else {
            const bool isq = u.pn < 4; const int h = isq ? u.pn : u.pn - 12; const int j0 = wc * 32 + fq * 8;
            const float lf = l2gam(h), lb = l2gam(3 - h);
#pragma unroll
            for (int ai = 0; ai < 2; ++ai) { float rs4[4]; rows_rs4(ss, g * TG + u.pm * 256 + ai * 128 + wr * 64 + fr, fq, rs4);
                f32x4 tb[2][4];
                { const int pos = (u.pm * 256 + ai * 128 + wr * 64 + fr) & 4095; tb[0][0] = *(const f32x4*)(cost + pos * 128 + j0); tb[0][1] = *(const f32x4*)(cost + pos * 128 + j0 + 4);
                  tb[0][2] = *(const f32x4*)(sint + pos * 128 + j0); tb[0][3] = *(const f32x4*)(sint + pos * 128 + j0 + 4); }
#pragma unroll
                for (int m = 0; m < 4; ++m) if (epi_fence()) { const int r = ai * 128 + wr * 64 + m * 16 + fr, rowg = u.pm * 256 + r; const float rs = rs4[m];
                    if (m < 3) { const int pn_ = (rowg + 16) & 4095; tb[(m + 1) & 1][0] = *(const f32x4*)(cost + pn_ * 128 + j0); tb[(m + 1) & 1][1] = *(const f32x4*)(cost + pn_ * 128 + j0 + 4);
                        tb[(m + 1) & 1][2] = *(const f32x4*)(sint + pn_ * 128 + j0); tb[(m + 1) & 1][3] = *(const f32x4*)(sint + pn_ * 128 + j0 + 4); }
                    const f32x4 c0 = tb[m & 1][0], c1 = tb[m & 1][1], s0 = tb[m & 1][2], s1 = tb[m & 1][3];
                    const f32x4 x10 = acc[ai][0][m][0] * rs, x11 = acc[ai][0][m][1] * rs, x20 = acc[ai][1][m][0] * rs, x21 = acc[ai][1][m][1] * rs;
                    const f32x4 o10 = x10 * c0 - x20 * s0, o11 = x11 * c1 - x21 * s1, o20 = x20 * c0 + x10 * s0, o21 = x21 * c1 + x11 * s1;
                    if (isq) {
                        const float wf = ex2(lf * (float)(r + 1)), wb = ex2(lb * (float)(256 - r));
                        bf16_t* p = a2 + ((size_t)(((bl * 4 + h) * 16 + cc) * 256 + r)) * 768 + 256 + j0;
                        ST16((p), pack8(o10 * wf, o11 * wf)); ST16((p + 128), pack8(o20 * wf, o21 * wf));
                        ST16((p + 256), pack8(o10 * wb, o11 * wb)); ST16((p + 384), pack8(o20 * wb, o21 * wb));
                    } else {
                        bf16_t* p = kb + (size_t)rowg * 1024 + h * 256 + j0;
                        ST16((p), pack8(o10 * 0.0625f, o11 * 0.0625f)); ST16((p + 128), pack8(o20 * 0.0625f, o21 * 0.0625f));
                    } } }
        }
    }
};
struct EpiRetB {
    const float* ss; bf16_t* bt2; int g;
    __device__ __forceinline__ void operator()(EPI_ARGS) const {
        const int bl = u.pn >> 4, cc = u.pn & 15;
#pragma unroll
        for (int bj = 0; bj < 2; ++bj) {
            const int jt0 = bj * 128 + wc * 32 + fq * 8, tl0 = u.pn * 256 + jt0;
            f32x4 rs0, rs1;
#pragma unroll
            for (int e = 0; e < 4; ++e) { rs0[e] = row_rs(ss, g * TG + tl0 + e); rs1[e] = row_rs(ss, g * TG + tl0 + 4 + e); }
            FOR_AI_M { const int vrow = u.pm * 256 + ai * 128 + wr * 64 + m * 16 + fr, h = vrow >> 9, dv = vrow & 511;
                ST16((bt2 + ((size_t)(((bl * 4 + h) * 16 + cc) * 512 + dv)) * 768 + jt0), pack8(acc[ai][bj][m][0] * rs0, acc[ai][bj][m][1] * rs1)); }
        }
    }
};
struct EpiScore {
    bf16_t* a2;
    __device__ __forceinline__ void operator()(EPI_ARGS) const {
        const int h = (u.z >> 4) & 3; const float lf = l2gam(h), lb = l2gam(3 - h);
        FOR_AI_M { const int jn = ai * 128 + wr * 64 + m * 16 + fr;
#pragma unroll
            for (int bj = 0; bj < 2; ++bj) { const int jm0 = bj * 128 + wc * 32 + fq * 8; f32x4 p0, p1;
#pragma unroll
                for (int e = 0; e < 4; ++e) { const int ja = jm0 + e, jb = jm0 + 4 + e;
                    const float ea = -lf * (float)(min(ja, jn) + 1) + lb * (float)max(ja - jn, 0);
                    const float eb = -lf * (float)(min(jb, jn) + 1) + lb * (float)max(jb - jn, 0);
                    p0[e] = acc[ai][bj][m][0][e] * ex2(ea); p1[e] = acc[ai][bj][m][1][e] * ex2(eb); }
                ST16((a2 + ((size_t)(u.z * 256 + jn)) * 768 + jm0), pack8(p0, p1)); } }
    }
};
struct EpiKv {
    bf16_t* bt2;
    __device__ __forceinline__ void operator()(EPI_ARGS) const {
        FOR_AI_M { const int r = ai * 128 + wr * 64 + m * 16 + fr;
            bf16_t* p = bt2 + ((size_t)(u.z * 512 + u.pm * 256 + r)) * 768 + 256 + u.pn * 256 + wc * 32 + fq * 8;
#pragma unroll
            for (int bj = 0; bj < 2; ++bj) ST16((p + bj * 128), pack8(acc[ai][bj][m][0], acc[ai][bj][m][1])); }
    }
};
struct EpiY {
    bf16_t* yz; float* yss; const bf16_t* sg; int g;
    __device__ __forceinline__ void operator()(EPI_ARGS) const {
        const int bl = u.z >> 6, h = (u.z >> 4) & 3, cc = u.z & 15;
#pragma unroll
        for (int ai = 0; ai < 2; ++ai) { u32x4 gw8[8];
#pragma unroll
          for (int i = 0; i < 8; ++i) gw8[i] = *(const u32x4*)(sg + (size_t)(bl * 4096 + cc * 256 + ai * 128 + wr * 64 + (i >> 1) * 16 + fr) * 2048 + h * 512 + u.pn * 256 + wc * 32 + fq * 8 + (i & 1) * 128);
#pragma unroll
          for (int m = 0; m < 4; ++m) if (epi_fence()) { const int r = ai * 128 + wr * 64 + m * 16 + fr, tok = g * TG + bl * 4096 + cc * 256 + r; float sq = 0.f;
            bf16_t* p = yz + (size_t)tok * 2048 + h * 512 + u.pn * 256 + wc * 32 + fq * 8;
#pragma unroll
            for (int bj = 0; bj < 2; ++bj) { const f32x4 v0 = acc[ai][bj][m][0], v1 = acc[ai][bj][m][1];
                const u32x4 gw_ = gw8[m * 2 + bj];
                ST16((p + bj * 128), pack8(v0 * unlo(gw_), v1 * unhi(gw_)));
                sq += (v0[0] * v0[0] + v0[1] * v0[1]) + (v0[2] * v0[2] + v0[3] * v0[3]) + (v1[0] * v1[0] + v1[1] * v1[1]) + (v1[2] * v1[2] + v1[3] * v1[3]); }
            sq += __shfl_xor(sq, 16); sq += __shfl_xor(sq, 32);
            if (fq == 0) yss[(size_t)(tok * 4 + h) * 8 + u.pn * 4 + wc] = sq; } }
    }
};

__device__ __forceinline__ float wave_sum(float v) {
#pragma unroll
    for (int o = 1; o < 64; o <<= 1) v += __shfl_xor(v, o);
    return v;
}
__device__ __forceinline__ void tr_load(const float* W, int ldw, int nblk, int item, int lane, f32x4 (&v)[8]) {
    const int kb = item / nblk, nb = item % nblk, k0 = 64 * kb, n0 = 32 * nb, n4 = (lane & 7) * 4;
#pragma unroll
    for (int i = 0; i < 8; ++i) v[i] = *(const f32x4*)(W + (size_t)(k0 + i * 8 + (lane >> 3)) * ldw + n0 + n4);
}
__device__ __forceinline__ void tr_finish(const f32x4 (&v)[8], int K, int nblk, bf16_t* WT, LAS float* scr, int item, int lane, const float* gain) {
    const int kb = item / nblk, nb = item % nblk, k0 = 64 * kb, n0 = 32 * nb, n4 = (lane & 7) * 4;
#pragma unroll
    for (int i = 0; i < 8; ++i) { const int kk = i * 8 + (lane >> 3); const float gv = gain ? gain[k0 + kk] : 1.0f;
#pragma unroll
        for (int e = 0; e < 4; ++e) scr[kk * 33 + n4 + e] = v[i][e] * gv; }
    asm volatile("s_waitcnt lgkmcnt(0)" ::: "memory");
    const int c = lane & 7;
#pragma unroll
    for (int j = 0; j < 4; ++j) { const int n = (lane >> 3) + 8 * j; const LAS float* s = scr + (8 * c) * 33 + n;
        u32x4 o; o.x = cvt_pk_bf16(s[0 * 33], s[1 * 33]); o.y = cvt_pk_bf16(s[2 * 33], s[3 * 33]); o.z = cvt_pk_bf16(s[4 * 33], s[5 * 33]); o.w = cvt_pk_bf16(s[6 * 33], s[7 * 33]);
        ST16((WT + (size_t)(n0 + n) * K + k0 + 8 * c), o); }
    asm volatile("s_waitcnt lgkmcnt(0)" ::: "memory");
}
__device__ __forceinline__ void tr_item(const float* W, int ldw, int K, int nblk, bf16_t* WT, LAS float* scr, int item, int lane, const float* gain) {
    f32x4 v[8]; tr_load(W, ldw, nblk, item, lane, v); tr_finish(v, K, nblk, WT, scr, item, lane, gain);
}
__device__ __forceinline__ void tr_job(const float* W, int ldw, int K, int N, bf16_t* WT, const float* gain, LAS float* scr, int gw, int NGW, int lane) {
    const int nblk = N / 32, nitems = (K / 64) * nblk;
    for (int it = gw; it < nitems; it += NGW) tr_item(W, ldw, K, nblk, WT, scr, it, lane, gain);
}


#define SS1 ((float*)(ws + WS_SS1))
#define SS2 ((float*)(ws + WS_SS2))
#define SS3 ((float*)(ws + WS_SS3))
#define SS4 ((float*)(ws + WS_SS4))
#define YSS ((float*)(ws + WS_YSS))
#define COST ((float*)(ws + WS_COST))
#define SINT ((float*)(ws + WS_SINT))
#define COSJ ((float*)(ws + WS_COSJ))
#define SINJ ((float*)(ws + WS_SINJ))
#define CLA ((float*)(ws + WS_CLA))
#define WIN ((bf16_t*)(ws + WS_WIN))
#define WGA ((bf16_t*)(ws + WS_WGA))
#define WGX ((bf16_t*)(ws + WS_WGX))
#define WLO ((bf16_t*)(ws + WS_WLO))
#define WFG ((bf16_t*)(ws + WS_WFG))
#define WFU ((bf16_t*)(ws + WS_WFU))
#define WFD ((bf16_t*)(ws + WS_WFD))
#define WRI ((bf16_t*)(ws + WS_WRI))
#define WRO ((bf16_t*)(ws + WS_WRO))
#define XN ((bf16_t*)(ws + WS_XN))
#define XBP ((bf16_t*)(ws + WS_XBP))
#define GG ((bf16_t*)(ws + WS_GG))
#define XB ((bf16_t*)(ws + WS_XB))
#define YL ((bf16_t*)(ws + WS_YL))
#define ACT ((bf16_t*)(ws + WS_ACT))
#define YZ ((bf16_t*)(ws + WS_YZ))
#define A2 ((bf16_t*)(ws + WS_A2))
#define KB ((bf16_t*)(ws + WS_KB))
#define KTF ((bf16_t*)(ws + WS_KTF))
#define KTB ((bf16_t*)(ws + WS_KTB))
#define BT2 ((bf16_t*)(ws + WS_BT2))
#define SG ((bf16_t*)(ws + WS_SG))
#define INF ((bf16_t*)(ws + WS_INF))
#define INB ((bf16_t*)(ws + WS_INB))
#define LAF ((unsigned short*)(ws + WS_LAF))
#define LAB ((unsigned short*)(ws + WS_LAB))

#ifndef PHMASK
#define PHMASK 0xFFFFFFFFu
#endif
#define PHX(k) ((PHMASK >> (k)) & 1u)
#ifndef REPMASK
#define REPMASK 0u
#endif
#define NREP(k) (1 + (int)((REPMASK >> (k)) & 1u))
#ifndef SUBMASK
#define SUBMASK 3u
#endif

#ifdef DBG
constexpr size_t WS_DBG = 9 * MiB + 65536, WS_DBGBUF = 9 * MiB + 131072;
__device__ __forceinline__ float bfv(const bf16_t* p, size_t i) { return __uint_as_float((unsigned)p[i] << 16); }
__device__ __forceinline__ float hfv(const unsigned short* p, size_t i) { unsigned short v = p[i]; _Float16 h = __builtin_bit_cast(_Float16, v); return (float)h; }
__device__ __forceinline__ bool close_(float got, float ref, float rtol, float atol) { return fabsf(got - ref) <= atol + rtol * fabsf(ref); }
__device__ __forceinline__ unsigned hsh(unsigned x) { x ^= x >> 16; x *= 0x7feb352dU; x ^= x >> 15; x *= 0x846ca68bU; x ^= x >> 16; return x; }
__device__ __forceinline__ float bfr(float x) { unsigned u = __float_as_uint(x); u += 0x7fffu + ((u >> 16) & 1u); return __uint_as_float(u & 0xffff0000u); }
#define DFAIL(code) do { if (__hip_atomic_load(dbg, __ATOMIC_RELAXED, __HIP_MEMORY_SCOPE_AGENT) == 0u) atomicCAS(dbg, 0u, (unsigned)(code)); } while (0)
#define DCHK(code, got, ref, rtol, atol) do { if (!close_((got), (ref), (rtol), (atol))) DFAIL(code); } while (0)
#endif

#define XB_TMO      128
#define XB_XCNT(j)  (256  + 64 * (j))
#define XB_XSUB(j)  (1280 + 64 * (j))
#define XB_XGEN(j)  (2304 + 64 * (j))
#define XB_TOP      3328
#define XB_TOPGEN   3392
#define XCD_BAR_WORDS 3456
#define XB_SPIN_CAP (1u << 22)
constexpr size_t WS_BAR = 9 * MiB + 16384;
constexpr int MISC_OFF = 131072 + 320;
__device__ __forceinline__ unsigned xb_ld(unsigned* p)              { return __hip_atomic_load(p, __ATOMIC_RELAXED, __HIP_MEMORY_SCOPE_AGENT); }
__device__ __forceinline__ unsigned xb_add(unsigned* p, unsigned v) { return __hip_atomic_fetch_add(p, v, __ATOMIC_RELAXED, __HIP_MEMORY_SCOPE_AGENT); }
__device__ __forceinline__ unsigned xb_xcc_id() { return (unsigned)__builtin_amdgcn_s_getreg((3 << 11) | 20) & 0xFu; }
#define XB_SPIN(cond, bar) do { unsigned _sp = 0; while (cond) { __builtin_amdgcn_s_sleep(1); \
    if ((++_sp & 255u) == 0u) { if (xb_ld(&(bar)[XB_TMO])) break; if (_sp > XB_SPIN_CAP) { atomicAdd(&(bar)[XB_TMO], 1u); break; } } } } while (0)
struct XcdBarrier { unsigned* bar; unsigned x; volatile LAS unsigned* st; };
__device__ __forceinline__ XcdBarrier xcd_barrier_post(unsigned* bar, volatile LAS unsigned* st) {
    XcdBarrier b; b.bar = bar; b.x = xb_xcc_id(); b.st = st;
    if (threadIdx.x == 0) (void)xb_add(&bar[XB_XCNT(b.x)], 1u);
    return b;
}
__device__ __forceinline__ void xcd_barrier_complete(unsigned* bar, unsigned x, unsigned& nloc, unsigned& nx) {
    const unsigned G = gridDim.x * gridDim.y * gridDim.z;
    unsigned sum, cnt, mine, sp = 0u;
    for (;;) {
        sum = 0u; cnt = 0u; mine = 0u;
#pragma unroll
        for (unsigned j = 0; j < 16; ++j) { const unsigned c = xb_ld(&bar[XB_XCNT(j)]); sum += c; cnt += (c > 0u) ? 1u : 0u; mine = (j == x) ? c : mine; }
        if (sum == G) break;
        __builtin_amdgcn_s_sleep(1);
        if ((++sp & 255u) == 0u) { if (xb_ld(&bar[XB_TMO])) break; if (sp > XB_SPIN_CAP) { atomicAdd(&bar[XB_TMO], 1u); break; } }
    }
    nloc = mine > 0u ? mine : 1u; nx = cnt > 0u ? cnt : 1u;
}
__device__ __forceinline__ void xcd_barrier(const XcdBarrier& b) {
    asm volatile("s_waitcnt vmcnt(0)" ::: "memory");
    __syncthreads();
    if (threadIdx.x == 0) {
        unsigned* bar = b.bar; unsigned bx = xb_xcc_id(); asm volatile("" : "+s"(bar), "+s"(bx));
        __builtin_amdgcn_s_waitcnt(0);
        unsigned nloc = b.st[0], nx = b.st[1];
        if (nloc == 0u) { xcd_barrier_complete(bar, bx, nloc, nx); b.st[0] = nloc; b.st[1] = nx; }
        const unsigned old = xb_add(&bar[XB_XSUB(bx)], 1u);
        const unsigned gen = old / nloc;
        if (old + 1u == (gen + 1u) * nloc) {
            __builtin_amdgcn_fence(__ATOMIC_RELEASE, "agent");
            asm volatile("s_waitcnt vmcnt(0)" ::: "memory");
            const unsigned og = xb_add(&bar[XB_TOP], 1u);
            const unsigned tg = og / nx;
            if (og + 1u == (tg + 1u) * nx) xb_add(&bar[XB_TOPGEN], 1u);
            else { unsigned sp_ = 0; while (xb_ld(&bar[XB_TOPGEN]) == tg) { if ((++sp_ & 1023u) == 0u) { if (xb_ld(&bar[XB_TMO])) break; if (sp_ > (XB_SPIN_CAP << 2)) { atomicAdd(&bar[XB_TMO], 1u); break; } } } }
            __builtin_amdgcn_fence(__ATOMIC_ACQUIRE, "agent");
            xb_add(&bar[XB_XGEN(bx)], 1u);
            asm volatile("s_waitcnt vmcnt(0)" ::: "memory");
        } else {
            XB_SPIN(xb_ld(&bar[XB_XGEN(bx)]) == gen, bar);
            __builtin_amdgcn_fence(__ATOMIC_ACQUIRE, "agent");
            asm volatile("s_waitcnt vmcnt(0)" ::: "memory");
        }
    }
    __syncthreads();
}

struct Args { const float* in[18]; float* out; unsigned char* ws; int ph_lo, ph_hi; };


#ifdef DBG
__device__ __forceinline__ void dbg_check(int p, const Args& args, int tid) {
    unsigned char* ws = args.ws; unsigned* dbg = (unsigned*)(ws + WS_DBG); float* dbuf = (float*)(ws + WS_DBGBUF);
    const float* x = args.in[0]; const float* ln_mix = args.in[1]; const float* ln_ffn = args.in[2]; float* out = args.out;
    const unsigned r = hsh(tid * 7u + 1u + 977u * (unsigned)p);
    if (p == 0) {
        { const int n = r % 2048, k = (r >> 11) % 1024; DCHK(10, bfv(WIN, (size_t)n * 1024 + k), args.in[4][(size_t)k * 2048 + n], 0.008f, 1e-6f); }
        { const int mat = r % 8, j = (r >> 3) % 256, k = (r >> 11) % 256; DCHK(11, bfv(WGA, (size_t)mat * 65536 + j * 256 + k), args.in[7][(size_t)mat * 65536 + k * 256 + j], 0.008f, 1e-6f);
          DCHK(11, bfv(WGX, (size_t)mat * 65536 + j * 256 + k), args.in[9][(size_t)mat * 65536 + k * 256 + j], 0.008f, 1e-6f); }
        { const int l = r & 1, n = (r >> 1) % FF, k = (r >> 13) % 1024; const float gv = ln_ffn[l * 1024 + k];
          DCHK(12, bfv(WFG, (size_t)l * FF * 1024 + (size_t)n * 1024 + k), args.in[15][(size_t)l * 1024 * FF + (size_t)k * FF + n] * gv, 0.008f, 1e-6f);
          DCHK(12, bfv(WFU, (size_t)l * FF * 1024 + (size_t)n * 1024 + k), args.in[16][(size_t)l * 1024 * FF + (size_t)k * FF + n] * gv, 0.008f, 1e-6f); }
        { const int l = r & 1, n = (r >> 1) % 1024, k = (r >> 11) % FF; DCHK(13, bfv(WFD, (size_t)l * FF * 1024 + (size_t)n * FF + k), args.in[17][(size_t)l * FF * 1024 + (size_t)k * 1024 + n], 0.008f, 1e-6f); }
        { const int n = r % 6144, k = (r >> 13) % 1024; const int col = n < 1024 ? n : (n < 3072 ? 4096 + (n - 1024) : (n < 4096 ? 1024 + (n - 3072) : 2048 + (n - 4096)));
          DCHK(14, bfv(WRI, (size_t)n * 1024 + k), args.in[13][(size_t)k * 6144 + col] * ln_mix[1024 + k], 0.008f, 1e-6f); }
        { const int row = r % T, col = (r >> 15) % 1024; float ss = 0.f; for (int k = 0; k < 1024; ++k) { const float v = x[(size_t)row * 1024 + k]; ss += v * v; }
          DCHK(15, bfv(XN, (size_t)row * 1024 + col), x[(size_t)row * 1024 + col] * (1.0f / sqrtf(ss / 1024.0f + EPS)) * ln_mix[col], 0.01f, 1e-5f); }
        { const int pos = r % 4096, j = (r >> 12) % 128; const double ang = (double)pos * exp(-((double)j / 127.0) * 9.210340371976184);
          DCHK(16, COST[pos * 128 + j], (float)cos(ang), 0.f, 2e-3f); DCHK(16, SINT[pos * 128 + j], (float)sin(ang), 0.f, 2e-3f);
          DCHK(16, COSJ[j * 4096 + pos], (float)cos(ang), 0.f, 2e-3f); DCHK(16, SINJ[j * 4096 + pos], (float)sin(ang), 0.f, 2e-3f); }
        { const int n = r % 1024, k = (r >> 10) % 1024; DCHK(17, bfv(WLO, (size_t)n * 1024 + k), args.in[12][(size_t)k * 1024 + n], 0.008f, 1e-6f);
          const int k2 = (r >> 10) % 2048; DCHK(17, bfv(WRO, (size_t)n * 2048 + k2), args.in[14][(size_t)k2 * 1024 + n], 0.008f, 1e-6f); }
    } else if (p == 1) {
        const int row = r % T, col = (r >> 15) % 2048; float ref = 0.f;
        for (int k = 0; k < 1024; ++k) ref += bfv(XN, (size_t)row * 1024 + k) * bfv(WIN, (size_t)col * 1024 + k);
        if (col < 1024) DCHK(20, bfv(XBP, (size_t)row * 1024 + col), ref, 0.01f, 2e-3f);
        else { const int ch = col - 1024, b = row >> 12, t = row & 4095; const float u = 0.7978845608f * (ref + 0.044715f * ref * ref * ref);
            DCHK(21, bfv(GG, ((size_t)((b * 32 + ch / 32) * 4096 + t)) * 32 + ch % 32), 0.5f * ref * (1.0f + tanhf(u)), 0.02f, 3e-3f); }
    } else if (p == 2) {
        const int row = r % T, ch = (r >> 15) % 1024, pos = row & 4095; float ref = args.in[6][ch];
        for (int j = 0; j < 4; ++j) { const int pp = pos + j - 2; if (pp >= 0 && pp < 4096) ref += args.in[5][j * 1024 + ch] * bfv(XBP, (size_t)(row + j - 2) * 1024 + ch); }
        DCHK(30, bfv(XB, (size_t)row * 1024 + ch), ref, 0.01f, 2e-3f);
    } else if (p == 3) {
        const int row = r % T, ch = (r >> 15) % 1024, d = (r >> 25) & 1, z = ch >> 8, j = ch & 255, b = row >> 12, t = row & 4095; float pa = args.in[8][d * 1024 + ch], px = args.in[10][d * 1024 + ch];
        for (int k = 0; k < 256; ++k) { const float xv = bfv(XB, (size_t)row * 1024 + z * 256 + k); pa += xv * bfv(WGA, (size_t)((d * 4 + z) * 256 + j) * 256 + k); px += xv * bfv(WGX, (size_t)((d * 4 + z) * 256 + j) * 256 + k); }
        const float rr = 1.0f / (1.0f + expf(-pa)), ii = 1.0f / (1.0f + expf(-px)); const float la2 = rr * CLA[d * 1024 + ch]; const float a = exp2f(la2);
        const float inp = ii * bfv(XB, (size_t)row * 1024 + ch); (void)a;
        const size_t off = ((size_t)((b * 32 + ch / 32) * 4096 + t)) * 32 + ch % 32;
        DCHK(40 + d, hfv(d ? LAB : LAF, off), la2, 0.02f, 1e-5f); DCHK(42 + d, bfv(d ? INB : INF, off), inp, 0.03f, 2e-3f);
        { const float lam = args.in[11][d * 1024 + ch]; DCHK(44, CLA[d * 1024 + ch], -8.0f * log1pf(expf(-lam)) * 1.4426950408889634f, 1e-3f, 1e-7f); }
    } else if (p == 4) {
        { const float* dc = dbuf + 16384; const int ch = tid & 31, sc = (tid >> 5) * 8 + (r % 8); const size_t sl = ch; float hf = 0.f, hb = 0.f;
          for (int q = 0; q < sc * 32; ++q) hf = ({ const float a_ = exp2f(hfv(LAF, sl + (size_t)q * 32)); a_ * hf + sqrtf(fmaxf(1.0f - a_ * a_, 0.f)) * bfv(INF, sl + (size_t)q * 32); });
          for (int q = 4095; q >= (sc + 1) * 32; --q) hb = ({ const float a_ = exp2f(hfv(LAB, sl + (size_t)q * 32)); a_ * hb + sqrtf(fmaxf(1.0f - a_ * a_, 0.f)) * bfv(INB, sl + (size_t)q * 32); });
          { const float* d2 = dbuf + 32768; float ls = 0.f, hl = 0.f; for (int q = sc * 32; q < sc * 32 + 32; ++q) { const float l = hfv(LAF, sl + (size_t)q * 32); ls += l; { const float a_ = exp2f(l); hl = a_ * hl + sqrtf(fmaxf(1.0f - a_ * a_, 0.f)) * bfv(INF, sl + (size_t)q * 32); } }
            DCHK(57, d2[sc * 32 + ch], ls, 0.01f, 1e-4f); DCHK(58, d2[4096 + sc * 32 + ch], hl, 0.02f, 1e-2f); }
          DCHK(sc == 0 ? 51 : (sc == 1 ? 54 : (sc < 8 ? 55 : 56)), dc[sc * 32 + ch], hf, 0.02f, 1e-2f); DCHK(52, dc[4096 + sc * 32 + ch], hb, 0.02f, 1e-2f);
          const int t = sc * 32 + ((r >> 3) & 31); hf = 0.f; hb = 0.f;
          for (int q = 0; q <= t; ++q) hf = ({ const float a_ = exp2f(hfv(LAF, sl + (size_t)q * 32)); a_ * hf + sqrtf(fmaxf(1.0f - a_ * a_, 0.f)) * bfv(INF, sl + (size_t)q * 32); });
          for (int q = 4095; q >= t; --q) hb = ({ const float a_ = exp2f(hfv(LAB, sl + (size_t)q * 32)); a_ * hb + sqrtf(fmaxf(1.0f - a_ * a_, 0.f)) * bfv(INB, sl + (size_t)q * 32); });
          DCHK(53, bfv(YL, (size_t)t * 1024 + ch), (hf + hb) * bfv(GG, sl + (size_t)t * 32), 0.03f, 3e-2f); }
        const int b = r % 8, ch = (r >> 3) % 1024, t = (r >> 13) % 4096; const size_t slab = ((size_t)(b * 32 + ch / 32) * 4096) * 32 + ch % 32; float hf = 0.f, hb = 0.f;
        for (int q = 0; q <= t; ++q) hf = ({ const float a_ = exp2f(hfv(LAF, slab + (size_t)q * 32)); a_ * hf + sqrtf(fmaxf(1.0f - a_ * a_, 0.f)) * bfv(INF, slab + (size_t)q * 32); });
        for (int q = 4095; q >= t; --q) hb = ({ const float a_ = exp2f(hfv(LAB, slab + (size_t)q * 32)); a_ * hb + sqrtf(fmaxf(1.0f - a_ * a_, 0.f)) * bfv(INB, slab + (size_t)q * 32); });
        DCHK(50, bfv(YL, (size_t)(b * 4096 + t) * 1024 + ch), (hf + hb) * bfv(GG, slab + (size_t)t * 32), 0.03f, 3e-2f);
    } else if (p == 5) {
        const int row = r % T, col = (r >> 15) % 1024; float ref = x[(size_t)row * 1024 + col];
        for (int k = 0; k < 1024; ++k) ref += bfv(YL, (size_t)row * 1024 + k) * bfv(WLO, (size_t)col * 1024 + k);
        DCHK(60, out[(size_t)row * 1024 + col], ref, 0.01f, 5e-3f); DCHK(61, bfv(XN, (size_t)row * 1024 + col), ref, 0.02f, 5e-3f);
        float ss = 0.f; for (int k = 0; k < 1024; ++k) { const float v = out[(size_t)row * 1024 + k]; ss += v * v; }
        DCHK(62, SS1[row], ss, 0.01f, 1e-3f);
    } else if (p == 6) {
        const int row = r % T, j = (r >> 15) % FF; float g = 0.f, u = 0.f;
        for (int k = 0; k < 1024; ++k) { const float xv = bfv(XN, (size_t)row * 1024 + k); g += xv * bfv(WFG, (size_t)j * 1024 + k); u += xv * bfv(WFU, (size_t)j * 1024 + k); }
        const float rs = 1.0f / sqrtf(SS1[row] / 1024.0f + EPS); g *= rs; u *= rs;
        DCHK(70, bfv(ACT, (size_t)row * FF + j), g / (1.0f + expf(-g)) * u, 0.03f, 5e-3f);
        { const unsigned r2 = hsh(tid * 7u + 1u + 977u * 7u); const int row2 = r2 % T, col2 = (r2 >> 15) % 1024; dbuf[tid] = out[(size_t)row2 * 1024 + col2]; }
    } else if (p == 7) {
        const int row = r % T, col = (r >> 15) % 1024; float ref = dbuf[tid];
        for (int k = 0; k < FF; ++k) ref += bfv(ACT, (size_t)row * FF + k) * bfv(WFD, (size_t)col * FF + k);
        DCHK(80, out[(size_t)row * 1024 + col], ref, 0.01f, 5e-3f);
    } else if (p == 8) {
        const int tl = r % TG, h = (r >> 13) % 4, j = (r >> 15) % 128, pos = tl & 4095, jt = tl & 255, bl = tl >> 12, cc = (tl >> 8) & 15, z = (bl * 4 + h) * 16 + cc;
        const float rs = 1.0f / sqrtf(SS2[tl] / 1024.0f + EPS); const float cv = COST[pos * 128 + j], sv = SINT[pos * 128 + j];
        const float lf = l2gam(h), lb = l2gam(3 - h);
        { float x1 = 0.f, x2 = 0.f; for (int k = 0; k < 1024; ++k) { const float xv = bfv(XN, (size_t)tl * 1024 + k); x1 += xv * bfv(WRI, (size_t)(h * 256 + j) * 1024 + k); x2 += xv * bfv(WRI, (size_t)(h * 256 + 128 + j) * 1024 + k); }
          x1 *= rs; x2 *= rs; const float o1 = x1 * cv - x2 * sv, o2 = x2 * cv + x1 * sv; const float wf = exp2f(lf * (float)(jt + 1)), wb = exp2f(lb * (float)(256 - jt));
          const size_t base = ((size_t)(z * 256 + jt)) * 768;
          DCHK(90, bfv(A2, base + 256 + j), o1 * wf, 0.02f, 1e-3f); DCHK(90, bfv(A2, base + 384 + j), o2 * wf, 0.02f, 1e-3f);
          DCHK(90, bfv(A2, base + 512 + j), o1 * wb, 0.02f, 1e-3f); DCHK(90, bfv(A2, base + 640 + j), o2 * wb, 0.02f, 1e-3f); }
        { float x1 = 0.f, x2 = 0.f; for (int k = 0; k < 1024; ++k) { const float xv = bfv(XN, (size_t)tl * 1024 + k); x1 += xv * bfv(WRI, (size_t)(3072 + h * 256 + j) * 1024 + k); x2 += xv * bfv(WRI, (size_t)(3072 + h * 256 + 128 + j) * 1024 + k); }
          x1 *= rs; x2 *= rs; const float o1 = (x1 * cv - x2 * sv) * 0.0625f, o2 = (x2 * cv + x1 * sv) * 0.0625f;
          DCHK(91, bfv(KB, (size_t)tl * 1024 + h * 256 + j), o1, 0.02f, 1e-3f); DCHK(91, bfv(KB, (size_t)tl * 1024 + h * 256 + 128 + j), o2, 0.02f, 1e-3f);
          const float wf = exp2f(lf * (float)(255 - jt)), wb = exp2f(lb * (float)jt);
          DCHK(92, bfv(KTF, (size_t)(h * 256 + j) * TG + tl), o1 * wf, 0.02f, 1e-3f); DCHK(92, bfv(KTF, (size_t)(h * 256 + 128 + j) * TG + tl), o2 * wf, 0.02f, 1e-3f);
          DCHK(92, bfv(KTB, (size_t)(h * 256 + j) * TG + tl), o1 * wb, 0.02f, 1e-3f); DCHK(92, bfv(KTB, (size_t)(h * 256 + 128 + j) * TG + tl), o2 * wb, 0.02f, 1e-3f); }
        { const int col = (r >> 13) % 2048; float gv = 0.f, vv = 0.f; for (int k = 0; k < 1024; ++k) { const float xv = bfv(XN, (size_t)tl * 1024 + k); gv += xv * bfv(WRI, (size_t)(1024 + col) * 1024 + k); vv += xv * bfv(WRI, (size_t)(4096 + col) * 1024 + k); }
          gv *= rs; vv *= rs; DCHK(93, bfv(SG, (size_t)tl * 2048 + col), gv / (1.0f + expf(-gv)), 0.03f, 2e-3f);
          const int hv = col >> 9, dv = col & 511, zv = (bl * 4 + hv) * 16 + cc; DCHK(94, bfv(BT2, ((size_t)(zv * 512 + dv)) * 768 + jt), vv, 0.02f, 2e-3f); }
    } else if (p == 9) {
        { const int z = r % 128, jn = (r >> 7) % 256, jm = (r >> 15) % 256, bl = z >> 6, h = (z >> 4) & 3, cc = z & 15; float sp = 0.f;
          for (int d = 0; d < 256; ++d) sp += bfv(A2, ((size_t)(z * 256 + jn)) * 768 + 256 + d) * bfv(KB, ((size_t)bl * 4096 + cc * 256 + jm) * 1024 + h * 256 + d);
          const float lf = l2gam(h), lb = l2gam(3 - h); const float f = (jm <= jn) ? exp2f(-lf * (float)(jm + 1)) : exp2f(-lf * (float)(jn + 1) + lb * (float)(jm - jn));
          DCHK(100, bfv(A2, ((size_t)(z * 256 + jn)) * 768 + jm), sp * f, 0.02f, 2e-3f); }
        { const int z = r % 128, dir = (r >> 7) & 1, dv = (r >> 8) % 512, dk = (r >> 17) % 256, bl = z >> 6, h = (z >> 4) & 3, cc = z & 15; float kv = 0.f; const bf16_t* kt = dir ? KTB : KTF;
          for (int m = 0; m < 256; ++m) kv += bfv(BT2, ((size_t)(z * 512 + dv)) * 768 + m) * bfv(kt, (size_t)(h * 256 + dk) * TG + bl * 4096 + cc * 256 + m);
          DCHK(101, bfv(BT2, ((size_t)(z * 512 + dv)) * 768 + 256 + dir * 256 + dk), kv, 0.02f, 2e-3f);
          const int bh = z >> 4; for (int q = 0; q < 16; ++q) dbuf[tid * 16 + q] = bfv(BT2, ((size_t)((bh * 16 + q) * 512 + dv)) * 768 + 256 + dir * 256 + dk); }
    } else if (p == 10) {
        const unsigned r9 = hsh(tid * 7u + 1u + 977u * 9u); const int z = r9 % 128, dir = (r9 >> 7) & 1, dv = (r9 >> 8) % 512, dk = (r9 >> 17) % 256, bh = z >> 4, h = bh & 3;
        const float gch = exp2f(256.0f * l2gam(dir ? 3 - h : h)); float st = 0.f;
        if (dir == 0) { for (int q = 0; q < 16; ++q) { DCHK(110, bfv(BT2, ((size_t)((bh * 16 + q) * 512 + dv)) * 768 + 256 + dk), st, 0.02f, 2e-3f); st = st * gch + dbuf[tid * 16 + q]; } }
        else { for (int q = 15; q >= 0; --q) { DCHK(111, bfv(BT2, ((size_t)((bh * 16 + q) * 512 + dv)) * 768 + 512 + dk), st, 0.02f, 2e-3f); st = st * gch + dbuf[tid * 16 + q]; } }
    } else if (p == 11) {
        const int z = r % 128, jn = (r >> 7) % 256, dv = (r >> 15) % 512, bl = z >> 6, h = (z >> 4) & 3, cc = z & 15, tok = bl * 4096 + cc * 256 + jn; float y = 0.f;
        for (int k = 0; k < 768; ++k) y += bfv(A2, ((size_t)(z * 256 + jn)) * 768 + k) * bfv(BT2, ((size_t)(z * 512 + dv)) * 768 + k);
        DCHK(120, bfv(YZ, (size_t)tok * 2048 + h * 512 + dv), y, 0.02f, 3e-3f);
        float ssq = 0.f; for (int e = 0; e < 512; ++e) { const float v = bfv(YZ, (size_t)tok * 2048 + h * 512 + e); ssq += v * v; }
        DCHK(121, YSS[tok * 4 + h], ssq, 0.03f, 1e-4f);
        dbuf[8192 + tid] = bfv(YZ, (size_t)tok * 2048 + h * 512 + dv);
        if (tid < 64) {
            const float lf = l2gam(h), lb = l2gam(3 - h); const int n = cc * 256 + jn; float acc = 0.f;
            for (int m = 0; m < 4096; ++m) { float qk = 0.f; for (int d = 0; d < 256; ++d) qk += bfv(A2, ((size_t)(z * 256 + jn)) * 768 + 256 + d) * bfv(KB, ((size_t)bl * 4096 + m) * 1024 + h * 256 + d);
                const float w = (m <= n) ? exp2f(lf * (float)(n - m - jn - 1)) : exp2f(lb * (float)(m - n) - lf * (float)(jn + 1));
                const int zm = (bl * 4 + h) * 16 + (m >> 8); acc += qk * w * bfv(BT2, ((size_t)(zm * 512 + dv)) * 768 + (m & 255)); }
            DCHK(125, bfv(YZ, (size_t)tok * 2048 + h * 512 + dv), acc, 0.05f, 1e-2f); }
    } else if (p == 12) {
        const unsigned r11 = hsh(tid * 7u + 1u + 977u * 11u); const int z = r11 % 128, jn = (r11 >> 7) % 256, dv = (r11 >> 15) % 512, bl = z >> 6, h = (z >> 4) & 3, cc = z & 15, tok = bl * 4096 + cc * 256 + jn;
        const float rs = 1.0f / sqrtf(YSS[tok * 4 + h] / 512.0f + EPS);
        DCHK(130, bfv(YZ, (size_t)tok * 2048 + h * 512 + dv), dbuf[8192 + tid] * rs * bfv(SG, (size_t)tok * 2048 + h * 512 + dv), 0.02f, 2e-3f);
    } else if (p == 27) {
        const unsigned r2 = hsh(tid * 7u + 1u + 977u * 28u); const int row2 = r2 % T, col2 = (r2 >> 15) % 1024; dbuf[9216 + tid] = out[(size_t)row2 * 1024 + col2];
    } else if (p == 28) {
        const int row = r % T, col = (r >> 15) % 1024; float ref = dbuf[9216 + tid];
        for (int k = 0; k < 2048; ++k) ref += bfv(YZ, (size_t)row * 2048 + k) * bfv(WRO, (size_t)col * 2048 + k);
        DCHK(140, out[(size_t)row * 1024 + col], ref, 0.01f, 5e-3f);
    } else if (p == 29) {
        const int row = r % T, j = (r >> 15) % FF; float g = 0.f, u = 0.f;
        for (int k = 0; k < 1024; ++k) { const float xv = bfv(XN, (size_t)row * 1024 + k); g += xv * bfv(WFG, (size_t)FF * 1024 + (size_t)j * 1024 + k); u += xv * bfv(WFU, (size_t)FF * 1024 + (size_t)j * 1024 + k); }
        const float rs = 1.0f / sqrtf(SS3[row] / 1024.0f + EPS); g *= rs; u *= rs;
        DCHK(150, bfv(ACT, (size_t)row * FF + j), g / (1.0f + expf(-g)) * u, 0.03f, 5e-3f);
        { const unsigned r2 = hsh(tid * 7u + 1u + 977u * 30u); const int row2 = r2 % T, col2 = (r2 >> 15) % 1024; dbuf[9728 + tid] = out[(size_t)row2 * 1024 + col2]; }
    } else if (p == 30) {
        const int row = r % T, col = (r >> 15) % 1024; float ref = dbuf[9728 + tid];
        for (int k = 0; k < FF; ++k) ref += bfv(ACT, (size_t)row * FF + k) * bfv(WFD, (size_t)FF * 1024 + (size_t)col * FF + k);
        DCHK(160, out[(size_t)row * 1024 + col], ref, 0.01f, 5e-3f);
        { const unsigned r2 = hsh(tid * 7u + 1u + 977u * 31u); const int row2 = r2 % T, col2 = (r2 >> 15) % 1024; dbuf[10240 + tid] = out[(size_t)row2 * 1024 + col2]; }
    } else if (p == 31) {
        const int row = r % T, col = (r >> 15) % 1024;
        DCHK(170, out[(size_t)row * 1024 + col], dbuf[10240 + tid] * (1.0f / sqrtf(SS4[row] / 1024.0f + EPS)) * args.in[3][col], 0.01f, 1e-3f);
    }
}
__global__ void __launch_bounds__(512) dbg_kernel(Args args, int p) { dbg_check(p, args, (int)threadIdx.x); }
__global__ void __launch_bounds__(512) dbg_emit(Args args) { const unsigned code = *(const unsigned*)(args.ws + WS_DBG);
    if (code) for (int i = blockIdx.x * 512 + threadIdx.x; i < T * D; i += gridDim.x * 512) args.out[i] = 10.0f * (float)code; }
#endif

__global__ void __launch_bounds__(512, 2) mk_fwd(Args args) {
    extern __shared__ __attribute__((aligned(16))) unsigned char lds_raw[];
    LAS unsigned char* lds = (LAS unsigned char*)lds_raw;
    cg::grid_group grid = cg::this_grid();
    const int G = gridDim.x, c = blockIdx.x, NGW = G * 8, NGT = G * 512;
#define PH_VARS int tid = threadIdx.x; asm volatile("" : "+v"(tid)); const int lane = tid & 63, wave = __builtin_amdgcn_readfirstlane(tid >> 6), gw = c * 8 + wave, gt = c * 512 + tid; (void)lane; (void)gw; (void)gt;
    unsigned char* ws = args.ws;
    const float* x = args.in[0]; const float* ln_mix = args.in[1]; const float* ln_ffn = args.in[2]; const float* ln_fin = args.in[3];
    float* out = args.out;
#ifdef DBG
    const int lo = args.ph_lo, hi = args.ph_hi;
    int p = 0;
#endif
#define PH_ON (p >= lo && p < hi)
    volatile LAS unsigned* MISC = (volatile LAS unsigned*)(lds + MISC_OFF);
    if (threadIdx.x < 32) MISC[threadIdx.x] = 0u;
    __syncthreads();
    XcdBarrier xbar; xbar.bar = (unsigned*)(ws + WS_BAR); xbar.x = 0; xbar.st = MISC + 8;
#ifndef DBG
    xbar = xcd_barrier_post((unsigned*)(ws + WS_BAR), MISC + 8);
    if (args.ph_lo < 0) grid.sync();
#endif
#ifdef DBG
#define PH_END do { if (PH_ON && p + 1 < hi) { if (p == 0) { grid.sync(); xbar = xcd_barrier_post((unsigned*)(ws + WS_BAR), MISC + 8); } else xcd_barrier(xbar); } ++p; } while (0)
#define PH_END0 PH_END
#define PH_FINAL PH_END
#else
#undef PH_ON
#define PH_ON true
#define PH_END0 xcd_barrier(xbar)
#define PH_END xcd_barrier(xbar)
#define PH_FINAL do { } while (0)
#endif

    for (int rep_ = 0; rep_ < ((PH_ON && PHX(0)) ? NREP(0) : 0); ++rep_) { PH_VARS
#ifdef DBG
        if (gt == 0) *(unsigned*)(ws + WS_DBG) = 0u;
#endif
#ifdef DBG
        if (gt < XCD_BAR_WORDS) ((unsigned*)(ws + WS_BAR))[gt] = 0u;
#endif
        for (int i = gt; i < 4096 * 128; i += NGT) { const int pos = i >> 7, j = i & 127;
            const float invf = ex2(-(float)j * (13.287712379549449f / 127.0f)); const float ang = (float)pos * invf;
            double rd = (double)ang * 0.15915494309189535; rd -= floor(rd); const float fr_ = (float)rd;
            COST[i] = __builtin_amdgcn_cosf(fr_); SINT[i] = __builtin_amdgcn_sinf(fr_); }
        for (int i = gt; i < 4096 * 128; i += NGT) { const int j = i >> 12, pos = i & 4095;
            const float invf = ex2(-(float)j * (13.287712379549449f / 127.0f)); const float ang = (float)pos * invf;
            double rd = (double)ang * 0.15915494309189535; rd -= floor(rd); const float fr_ = (float)rd;
            COSJ[i] = __builtin_amdgcn_cosf(fr_); SINJ[i] = __builtin_amdgcn_sinf(fr_); }
        for (int i = gt; i < 2048; i += NGT) { const float lam = args.in[11][i]; CLA[i] = -8.0f * log1pf(expf(-lam)) * 1.4426950408889634f; }
        LAS float* scr = (LAS float*)(lds + wave * 16384);
#define TR_DECODE(IT0, W, ldw, K, N, WT, gain, it) do { it = (IT0); gain = nullptr; \
            if (it < 1024) { W = args.in[4]; ldw = 2048; K = 1024; N = 2048; WT = WIN; } \
            else if ((it -= 1024) < 512) { const int mat = it >> 5; it &= 31; W = (mat < 8 ? args.in[7] : args.in[9]) + (size_t)(mat & 7) * 65536; WT = (mat < 8 ? WGA : WGX) + (size_t)(mat & 7) * 65536; ldw = 256; K = 256; N = 256; } \
            else if ((it -= 512) < 512) { W = args.in[12]; ldw = 1024; K = 1024; N = 1024; WT = WLO; } \
            else if ((it -= 512) < 8448) { const int q = it / 1408; it -= q * 1408; const int l = q / 3, w = q - l * 3; \
                if (w == 0) { W = args.in[15] + (size_t)l * 1024 * FF; ldw = FF; K = 1024; N = FF; WT = WFG + (size_t)l * FF * 1024; gain = ln_ffn + l * 1024; } \
                else if (w == 1) { W = args.in[16] + (size_t)l * 1024 * FF; ldw = FF; K = 1024; N = FF; WT = WFU + (size_t)l * FF * 1024; gain = ln_ffn + l * 1024; } \
                else { W = args.in[17] + (size_t)l * 1024 * FF; ldw = 1024; K = FF; N = 1024; WT = WFD + (size_t)l * FF * 1024; } } \
            else if ((it -= 8448) < 3072) { ldw = 6144; K = 1024; gain = ln_mix + 1024; \
                if (it < 512) { W = args.in[13]; N = 1024; WT = WRI; } \
                else if ((it -= 512) < 512) { W = args.in[13] + 1024; N = 1024; WT = WRI + (size_t)3072 * 1024; } \
                else if ((it -= 512) < 1024) { W = args.in[13] + 2048; N = 2048; WT = WRI + (size_t)4096 * 1024; } \
                else { it -= 1024; W = args.in[13] + 4096; N = 2048; WT = WRI + (size_t)1024 * 1024; } } \
            else { it -= 3072; W = args.in[14]; ldw = 1024; K = 2048; N = 1024; WT = WRO; } } while (0)
        if (gw < 14592) {
            const float* W; const float* gain; bf16_t* WT; int ldw, K, N, it; f32x4 v[8];
            TR_DECODE(gw, W, ldw, K, N, WT, gain, it); tr_load(W, ldw, N / 32, it, lane, v);
            for (int it0 = gw; it0 < 14592; it0 += NGW) {
                const float* W2 = W; const float* gain2 = gain; bf16_t* WT2 = WT; int ldw2 = ldw, K2 = K, N2 = N, it2 = it; f32x4 v2[8];
                const bool more = it0 + NGW < 14592;
                if (more) { TR_DECODE(it0 + NGW, W2, ldw2, K2, N2, WT2, gain2, it2); tr_load(W2, ldw2, N2 / 32, it2, lane, v2); }
                tr_finish(v, K, N / 32, WT, scr, it, lane, gain);
                if (more) { W = W2; gain = gain2; WT = WT2; ldw = ldw2; K = K2; N = N2; it = it2;
#pragma unroll
                    for (int i = 0; i < 8; ++i) v[i] = v2[i]; }
            }
        }
#undef TR_DECODE
        for (int row = gw; row < T; row += 2 * NGW) {
            const int row2 = row + NGW; const bool has2 = row2 < T;
            const f32x4* xr = (const f32x4*)(x + (size_t)row * 1024) + lane; const f32x4* xr2 = (const f32x4*)(x + (size_t)(has2 ? row2 : row) * 1024) + lane;
            f32x4 v[4], v2[4]; float s = 0.f, s2 = 0.f;
#pragma unroll
            for (int j = 0; j < 4; ++j) { v[j] = xr[64 * j]; v2[j] = xr2[64 * j]; }
#pragma unroll
            for (int j = 0; j < 4; ++j) { s += (v[j][0] * v[j][0] + v[j][1] * v[j][1]) + (v[j][2] * v[j][2] + v[j][3] * v[j][3]); s2 += (v2[j][0] * v2[j][0] + v2[j][1] * v2[j][1]) + (v2[j][2] * v2[j][2] + v2[j][3] * v2[j][3]); }
            const float rs = rsq(wave_sum(s) * (1.0f / 1024.0f) + EPS), rs2 = rsq(wave_sum(s2) * (1.0f / 1024.0f) + EPS);
#pragma unroll
            for (int j = 0; j < 4; ++j) { const f32x4 gv = ((const f32x4*)ln_mix)[64 * j + lane]; const f32x4 o = v[j] * rs * gv, o2 = v2[j] * rs2 * gv;
                uint2 w; w.x = cvt_pk_bf16(o[0], o[1]); w.y = cvt_pk_bf16(o[2], o[3]); *(uint2*)(XN + (size_t)row * 1024 + (64 * j + lane) * 4) = w;
                if (has2) { uint2 w2; w2.x = cvt_pk_bf16(o2[0], o2[1]); w2.y = cvt_pk_bf16(o2[2], o2[3]); *(uint2*)(XN + (size_t)row2 * 1024 + (64 * j + lane) * 4) = w2; } }
        }
    }
    PH_END0;

    for (int rep_ = 0; rep_ < ((PH_ON && PHX(1)) ? NREP(1) : 0); ++rep_) {
        StdSched S{(const char*)XN, (const char*)WIN, 128, 8, 1024, 1024, G, c}; EpiP1 E{XBP, GG};
        pg8::gemm_phase(lds, 1024, 1024, 1024, S, E);
    }
    PH_END;

#ifdef EXTRA_BAR
    for (int eb_ = 0; eb_ < EXTRA_BAR; ++eb_) xcd_barrier(xbar);
#endif
    for (int rep_ = 0; rep_ < ((PH_ON && PHX(2)) ? NREP(2) : 0); ++rep_) { PH_VARS
        const float* cw = args.in[5]; const float* cb = args.in[6];
        for (int it = gt; it < 1024 * 128; it += NGT) {
            const int o = it & 127, s = it >> 7, t0 = s * 32, ch = o * 8, p0 = t0 & 4095;
            f32x4 w[4][2];
#pragma unroll
            for (int j = 0; j < 4; ++j) { w[j][0] = *(const f32x4*)(cw + j * 1024 + ch); w[j][1] = *(const f32x4*)(cw + j * 1024 + ch + 4); }
            const f32x4 b0 = *(const f32x4*)(cb + ch), b1 = *(const f32x4*)(cb + ch + 4);
            const bf16_t* src = XBP + (size_t)t0 * 1024 + ch; bf16_t* dst = XB + (size_t)t0 * 1024 + ch;
            const f32x4 zz = (f32x4){0.f, 0.f, 0.f, 0.f};
            f32x4 m2l = zz, m2h = zz, m1l = zz, m1h = zz, c0l, c0h;
            if (p0 != 0) { const u32x4 a = *(const u32x4*)(src - 2048), bq = *(const u32x4*)(src - 1024); m2l = unlo(a); m2h = unhi(a); m1l = unlo(bq); m1h = unhi(bq); }
            { const u32x4 a = *(const u32x4*)(src); c0l = unlo(a); c0h = unhi(a); }
#pragma unroll 8
            for (int i = 0; i < 32; ++i) {
                f32x4 p1l = zz, p1h = zz;
                if (p0 + i + 1 < 4096) { const u32x4 a = *(const u32x4*)(src + (size_t)(i + 1) * 1024); p1l = unlo(a); p1h = unhi(a); }
                const f32x4 yl = w[0][0] * m2l + w[1][0] * m1l + w[2][0] * c0l + w[3][0] * p1l + b0;
                const f32x4 yh = w[0][1] * m2h + w[1][1] * m1h + w[2][1] * c0h + w[3][1] * p1h + b1;
                ST16((dst + (size_t)i * 1024), pack8(yl, yh));
                m2l = m1l; m2h = m1h; m1l = c0l; m1h = c0h; c0l = p1l; c0h = p1h;
            }
        }
    }
    PH_END;

    for (int rep_ = 0; rep_ < ((PH_ON && PHX(3)) ? NREP(3) : 0); ++rep_) {
        GateSched S{(const char*)XB, (const char*)WGA, (const char*)WGX, G, c};
        EpiGate E{XB, args.in[8], args.in[10], CLA, LAF, INF, LAB, INB};
        pg8::gemm_phase(lds, 1024, 256, 256, S, E);
    }
    PH_END;

    for (int rep_ = 0; rep_ < ((PH_ON && PHX(4)) ? NREP(4) : 0); ++rep_) { PH_VARS
        const int o = tid & 3, s = tid >> 2;
        LAS float* CL = (LAS float*)lds; LAS float* CH = CL + 2 * 128 * 32;
        for (int it_ = c; it_ < 256; it_ += G) {
            const int item = (G == 256) ? ((it_ & 7) * 32 + (it_ >> 3)) : it_;
            const size_t slab = (size_t)item * 4096 * 32 + o * 8; const int b = item >> 5, cgp = item & 31;
            float L[8], H[8];
#pragma unroll
            for (int dir = 0; dir < 2; ++dir) {
#pragma unroll
                for (int k = 0; k < 8; ++k) { L[k] = 0.f; H[k] = 0.f; }
                const unsigned short* pl = (dir ? LAB : LAF) + slab + (size_t)s * 1024; const bf16_t* pq = (dir ? INB : INF) + slab + (size_t)s * 1024;
                asm volatile("" : "+v"(pl), "+v"(pq));
                u32x4 lbuf[2][4], qbuf[2][4];
#pragma unroll
                for (int j = 0; j < 4; ++j) { const int r0 = (dir ? 28 : 0) + j; lbuf[0][j] = *(const u32x4*)(pl + r0 * 32); qbuf[0][j] = *(const u32x4*)(pq + r0 * 32); }
#pragma unroll
                for (int gi = 0; gi < 8; ++gi) { const int gg_ = dir ? 7 - gi : gi;
                    if (gi < 7) { const int gn = dir ? gg_ - 1 : gg_ + 1;
#pragma unroll
                        for (int j = 0; j < 4; ++j) { lbuf[(gi + 1) & 1][j] = *(const u32x4*)(pl + (gn * 4 + j) * 32); qbuf[(gi + 1) & 1][j] = *(const u32x4*)(pq + (gn * 4 + j) * 32); } }
#pragma unroll
                    for (int jj = 0; jj < 4; ++jj) { const int j = dir ? 3 - jj : jj; const u32x4 lw = lbuf[gi & 1][j], iw = qbuf[gi & 1][j];
                        const f32x4 l0 = unlo_h(lw), l1 = unhi_h(lw), q0 = unlo(iw), q1 = unhi(iw);
#pragma unroll
                        for (int k = 0; k < 4; ++k) { lru_step(l0[k], q0[k], H[k]); L[k] += l0[k]; lru_step(l1[k], q1[k], H[4 + k]); L[4 + k] += l1[k]; } }
                    __builtin_amdgcn_sched_barrier(0); }
#pragma unroll
                for (int k = 0; k < 8; ++k) { CL[(dir * 128 + s) * 32 + o * 8 + k] = L[k]; CH[(dir * 128 + s) * 32 + o * 8 + k] = H[k]; }
            }
            __syncthreads();
#ifdef DBG
            if (item == 0) { float* dc = (float*)(ws + WS_DBGBUF) + 32768;
#pragma unroll
                for (int k = 0; k < 8; ++k) { dc[s * 32 + o * 8 + k] = CL[s * 32 + o * 8 + k]; dc[4096 + s * 32 + o * 8 + k] = CH[s * 32 + o * 8 + k]; } }
            __syncthreads();
#endif
            if (tid < 64) { const int dir = tid >> 5, ch = tid & 31; float cr = 0.f;
                if (dir == 0) { for (int q = 0; q < 128; ++q) { const int idx = q * 32 + ch; const float l = CL[idx], hh = CH[idx]; CH[idx] = cr; cr = ex2(l) * cr + hh; } }
                else { for (int q = 127; q >= 0; --q) { const int idx = (128 + q) * 32 + ch; const float l = CL[idx], hh = CH[idx]; CH[idx] = cr; cr = ex2(l) * cr + hh; } } }
            __syncthreads();
#ifdef DBG
            if (item == 0) { float* dc = (float*)(ws + WS_DBGBUF) + 16384;
#pragma unroll
                for (int k = 0; k < 8; ++k) { dc[s * 32 + o * 8 + k] = CH[s * 32 + o * 8 + k]; dc[4096 + s * 32 + o * 8 + k] = CH[(128 + s) * 32 + o * 8 + k]; } }
#endif
#pragma unroll
            for (int k = 0; k < 8; ++k) H[k] = CH[s * 32 + o * 8 + k];
            u32x4 hfp[32];
            {
                const unsigned short* pl = LAF + slab + (size_t)s * 1024; const bf16_t* pi = INF + slab + (size_t)s * 1024;
                asm volatile("" : "+v"(pl), "+v"(pi));
                u32x4 lbuf[2][4], qbuf[2][4];
#pragma unroll
                for (int j = 0; j < 4; ++j) { lbuf[0][j] = *(const u32x4*)(pl + j * 32); qbuf[0][j] = *(const u32x4*)(pi + j * 32); }
#pragma unroll
                for (int gi = 0; gi < 8; ++gi) {
                    if (gi < 7) {
#pragma unroll
                        for (int j = 0; j < 4; ++j) { lbuf[(gi + 1) & 1][j] = *(const u32x4*)(pl + ((gi + 1) * 4 + j) * 32); qbuf[(gi + 1) & 1][j] = *(const u32x4*)(pi + ((gi + 1) * 4 + j) * 32); } }
#pragma unroll
                    for (int j = 0; j < 4; ++j) { const u32x4 lw = lbuf[gi & 1][j], iw = qbuf[gi & 1][j];
                        const f32x4 l0 = unlo_h(lw), l1 = unhi_h(lw), q0 = unlo(iw), q1 = unhi(iw); f32x4 h0, h1;
#pragma unroll
                        for (int k = 0; k < 4; ++k) { lru_step(l0[k], q0[k], H[k]); lru_step(l1[k], q1[k], H[4 + k]); h0[k] = H[k]; h1[k] = H[4 + k]; }
                        hfp[gi * 4 + j] = pack8(h0, h1); }
                    __builtin_amdgcn_sched_barrier(0); }
            }
#pragma unroll
            for (int k = 0; k < 8; ++k) H[k] = CH[(128 + s) * 32 + o * 8 + k];
            {
                const unsigned short* pl = LAB + slab + (size_t)s * 1024; const bf16_t* pi = INB + slab + (size_t)s * 1024; const bf16_t* pg = GG + slab + (size_t)s * 1024;
                bf16_t* yp = YL + (size_t)(b * 4096 + s * 32 + 31) * 1024 + cgp * 32 + o * 8;
                asm volatile("" : "+v"(pl), "+v"(pi), "+v"(pg), "+v"(yp));
                u32x4 lbuf[2][2], qbuf[2][2], gbuf[2][2];
#pragma unroll
                for (int j = 0; j < 2; ++j) { lbuf[0][j] = *(const u32x4*)(pl + (30 + j) * 32); qbuf[0][j] = *(const u32x4*)(pi + (30 + j) * 32); gbuf[0][j] = *(const u32x4*)(pg + (30 + j) * 32); }
#pragma unroll
                for (int gi = 0; gi < 16; ++gi) { const int g2 = 15 - gi;
                    if (gi < 15) {
#pragma unroll
                        for (int j = 0; j < 2; ++j) { const int r_ = (g2 - 1) * 2 + j; lbuf[(gi + 1) & 1][j] = *(const u32x4*)(pl + r_ * 32); qbuf[(gi + 1) & 1][j] = *(const u32x4*)(pi + r_ * 32); gbuf[(gi + 1) & 1][j] = *(const u32x4*)(pg + r_ * 32); } }
#pragma unroll
                    for (int jj = 0; jj < 2; ++jj) { const int j = 1 - jj, i = g2 * 2 + j; const u32x4 lw = lbuf[gi & 1][j], iw = qbuf[gi & 1][j], gwv = gbuf[gi & 1][j], fw = hfp[i];
                        const f32x4 l0 = unlo_h(lw), l1 = unhi_h(lw), q0 = unlo(iw), q1 = unhi(iw), g0 = unlo(gwv), g1 = unhi(gwv), f0 = unlo(fw), f1 = unhi(fw); f32x4 y0, y1;
#pragma unroll
                        for (int k = 0; k < 4; ++k) { lru_step(l0[k], q0[k], H[k]); lru_step(l1[k], q1[k], H[4 + k]); y0[k] = (f0[k] + H[k]) * g0[k]; y1[k] = (f1[k] + H[4 + k]) * g1[k]; }
                        ST16(yp, pack8(y0, y1)); yp -= 1024; asm volatile("" : "+v"(yp)); }
                    if (gi & 1) __builtin_amdgcn_sched_barrier(0); }
            }
            __syncthreads();
        }
    }
    PH_END;

    for (int rep_ = 0; rep_ < ((PH_ON && PHX(5)) ? NREP(5) : 0); ++rep_) {
        StdSched S{(const char*)YL, (const char*)WLO, 128, 4, 1024, 1024, G, c}; EpiRes<true> E{x, XN, SS1, nullptr};
        pg8::gemm_phase(lds, 1024, 1024, 1024, S, E);
    }
    PH_END;
    for (int rep_ = 0; rep_ < ((PH_ON && PHX(6)) ? NREP(6) : 0); ++rep_) {
        FfnUpSched S{(const char*)XN, (const char*)WFG, (const char*)WFU, G, c}; EpiFfnUp E{SS1, ACT};
        pg8::gemm_phase(lds, 1024, 1024, 1024, S, E);
    }
    PH_END;
    for (int rep_ = 0; rep_ < ((PH_ON && PHX(7)) ? NREP(7) : 0); ++rep_) {
        StdSched S{(const char*)ACT, (const char*)WFD, 128, 4, FF, FF, G, c}; EpiRes<false> E{nullptr, XN, SS2, nullptr};
        pg8::gemm_phase(lds, FF, FF, FF, S, E);
    }
    PH_END;

#define NORM_PASS(gg) do { _Pragma("unroll 4") for (int it = gt; it < TG * 256; it += NGT) { const int row = it >> 8, o = it & 255, h = o >> 6; const int tok = (gg) * TG + row; \
        const float* yq_ = YSS + (size_t)(tok * 4 + h) * 8; const f32x4 ya_ = *(const f32x4*)yq_ + *(const f32x4*)(yq_ + 4); const float rs = rsq(((ya_[0] + ya_[1]) + (ya_[2] + ya_[3])) * (1.0f / 512.0f) + EPS); bf16_t* yp = YZ + (size_t)tok * 2048 + o * 8; const u32x4 yw = *(const u32x4*)yp; \
        ST16(yp, pack8(unlo(yw) * rs, unhi(yw) * rs)); } } while (0)
    for (int g = 0; g < NGRP; ++g) {
        const bf16_t* XNg = XN + (size_t)g * TG * 1024;
        for (int rep_ = 0; rep_ < ((PH_ON && PHX(8)) ? NREP(8) : 0); ++rep_) {
            if (SUBMASK & 1u) { StdSched S{(const char*)XNg, (const char*)WRI, 32, 16, 1024, 1024, G, c}; EpiRetA E{SS2, COST, SINT, A2, SG, KB, g};
              pg8::gemm_phase(lds, 1024, 1024, 1024, S, E); }
            if (SUBMASK & 2u) { StdSched S{(const char*)(WRI + (size_t)4096 * 1024), (const char*)XNg, 8, 32, 1024, 1024, G, c}; EpiRetB E{SS2, BT2, g};
              pg8::gemm_phase(lds, 1024, 1024, 1024, S, E); }
        }
        PH_END;
        for (int rep_ = 0; rep_ < ((PH_ON && PHX(9)) ? NREP(9) : 0); ++rep_) {
            { ScoreSched S{(const char*)A2, (const char*)KB, G, c}; EpiScore E{A2}; pg8::gemm_phase(lds, 768, 1024, 256, S, E); }
            const bool split = G >= 256;
            if (!split || c >= 128) { PH_VARS
                const int w0 = split ? (c - 128) * 8 + wave : gw, wst = split ? (G - 128) * 8 : NGW;
                LAS bf16_t* tb = (LAS bf16_t*)(lds + wave * 16384);
                for (int tile = w0; tile < 128 * 16; tile += wst) {
                    const int t0 = (tile >> 4) * 64, d0 = (tile & 15) * 64, h = d0 >> 8; const float lf = l2gam(h), lb = l2gam(3 - h);
#pragma unroll
                    for (int i = 0; i < 8; ++i) { const int row = i * 8 + (lane >> 3), cp = lane & 7;
                        *(LAS u32x4*)(tb + row * 72 + cp * 8) = *(const u32x4*)(KB + (size_t)(t0 + row) * 1024 + d0 + cp * 8); }
                    asm volatile("s_waitcnt lgkmcnt(0)" ::: "memory");
                    const int tp = lane & 7, jt0 = (t0 & 255) + tp * 8;
                    f32x4 wf0, wf1, wb0, wb1;
#pragma unroll
                    for (int e = 0; e < 4; ++e) { wf0[e] = ex2(lf * (float)(255 - (jt0 + e))); wf1[e] = ex2(lf * (float)(255 - (jt0 + 4 + e))); wb0[e] = ex2(lb * (float)(jt0 + e)); wb1[e] = ex2(lb * (float)(jt0 + 4 + e)); }
#pragma unroll
                    for (int i = 0; i < 8; ++i) { const int col = i * 8 + (lane >> 3); f32x4 k0, k1;
#pragma unroll
                        for (int e = 0; e < 4; ++e) { k0[e] = __uint_as_float((unsigned)tb[(tp * 8 + e) * 72 + col] << 16); k1[e] = __uint_as_float((unsigned)tb[(tp * 8 + 4 + e) * 72 + col] << 16); }
                        const size_t o = (size_t)(d0 + col) * TG + t0 + tp * 8;
                        ST16((KTF + o), pack8(k0 * wf0, k1 * wf1)); ST16((KTB + o), pack8(k0 * wb0, k1 * wb1)); }
                    asm volatile("s_waitcnt lgkmcnt(0)" ::: "memory");
                }
            }
        }
        PH_END;
        for (int rep_ = 0; rep_ < ((PH_ON && PHX(12)) ? NREP(12) : 0); ++rep_) {
            KvSched S{(const char*)BT2, (const char*)KTF, (const char*)KTB, G, c}; EpiKv E{BT2}; pg8::gemm_phase(lds, 768, TG, 256, S, E);
        }
        PH_END;
        for (int rep_ = 0; rep_ < ((PH_ON && PHX(10)) ? NREP(10) : 0); ++rep_) { PH_VARS
            for (int it = gt; it < 262144; it += NGT) {
                const int ok = it & 31, dv = (it >> 5) & 511, dir = (it >> 14) & 1, bh = it >> 15, h = bh & 3;
                const float gch = ex2(256.0f * l2gam(dir ? 3 - h : h));
                bf16_t* pb = BT2 + ((size_t)(bh * 16) * 512 + dv) * 768 + 256 + dir * 256 + ok * 8;
                u32x4 v[16];
#pragma unroll
                for (int q = 0; q < 16; ++q) v[q] = *(const u32x4*)(pb + (size_t)q * 512 * 768);
                f32x4 s0 = (f32x4){0.f, 0.f, 0.f, 0.f}, s1 = s0;
                if (dir == 0) {
#pragma unroll
                    for (int q = 0; q < 16; ++q) { ST16((pb + (size_t)q * 512 * 768), pack8(s0, s1)); s0 = s0 * gch + unlo(v[q]); s1 = s1 * gch + unhi(v[q]); }
                } else {
#pragma unroll
                    for (int q = 15; q >= 0; --q) { ST16((pb + (size_t)q * 512 * 768), pack8(s0, s1)); s0 = s0 * gch + unlo(v[q]); s1 = s1 * gch + unhi(v[q]); }
                }
            }
        }
        PH_END;
        for (int rep_ = 0; rep_ < ((PH_ON && PHX(11)) ? NREP(11) : 0); ++rep_) {
            YSched S{(const char*)A2, (const char*)BT2, G, c}; EpiY E{YZ, YSS, SG, g}; pg8::gemm_phase(lds, 768, 768, 768, S, E);
        }
        PH_END;
    }
    for (int rep_ = 0; rep_ < (PH_ON ? 1 : 0); ++rep_) { PH_VARS
        float* RQ = (float*)(ws + WS_RQ);
        for (int tok = gt; tok < T; tok += NGT) { float rsv[4];
#pragma unroll
            for (int h = 0; h < 4; ++h) { const float* yq_ = YSS + (size_t)(tok * 4 + h) * 8; const f32x4 ya_ = *(const f32x4*)yq_ + *(const f32x4*)(yq_ + 4);
                rsv[h] = rsq(((ya_[0] + ya_[1]) + (ya_[2] + ya_[3])) * (1.0f / 512.0f) + EPS); }
            *(f32x4*)(RQ + (size_t)tok * 4) = (f32x4){rsv[0] / rsv[1], rsv[1] / rsv[2], rsv[2] / rsv[3], rsv[3]}; }
    }
    PH_END;
    for (int rep_ = 0; rep_ < ((PH_ON && PHX(13)) ? NREP(13) : 0); ++rep_) {
        StdSched S{(const char*)YZ, (const char*)WRO, 128, 4, 2048, 2048, G, c}; EpiRes<false, true> E{nullptr, XN, SS3, (const float*)(ws + WS_RQ)};
        pg8::gemm_phase(lds, 2048, 2048, 2048, S, E, pg8::HeadRescale{(const float*)(ws + WS_RQ)});
    }
    PH_END;
    for (int rep_ = 0; rep_ < ((PH_ON && PHX(14)) ? NREP(14) : 0); ++rep_) {
        FfnUpSched S{(const char*)XN, (const char*)(WFG + (size_t)FF * 1024), (const char*)(WFU + (size_t)FF * 1024), G, c}; EpiFfnUp E{SS3, ACT};
        pg8::gemm_phase(lds, 1024, 1024, 1024, S, E);
    }
    PH_END;
    for (int rep_ = 0; rep_ < ((PH_ON && PHX(15)) ? NREP(15) : 0); ++rep_) {
        StdSched S{(const char*)ACT, (const char*)(WFD + (size_t)FF * 1024), 128, 4, FF, FF, G, c}; EpiRes<false> E{nullptr, XN, SS4, nullptr};
        pg8::gemm_phase(lds, FF, FF, FF, S, E);
    }
    PH_END;
    for (int rep_ = 0; rep_ < ((PH_ON && PHX(16)) ? NREP(16) : 0); ++rep_) { PH_VARS
        for (int row = gw; row < T; row += 2 * NGW) { const int row2 = row + NGW < T ? row + NGW : row;
            const f32x4* sp = (const f32x4*)(SS4 + (size_t)row * 16); const f32x4* sp2 = (const f32x4*)(SS4 + (size_t)row2 * 16);
            const f32x4 a0 = sp[0], a1 = sp[1], a2_ = sp[2], a3 = sp[3], b0 = sp2[0], b1 = sp2[1], b2_ = sp2[2], b3 = sp2[3];
            const uint2* hrow = (const uint2*)(XN + (size_t)row * 1024) + lane; const uint2* hrow2 = (const uint2*)(XN + (size_t)row2 * 1024) + lane;
            uint2 hw[4], hw2[4];
#pragma unroll
            for (int j = 0; j < 4; ++j) { hw[j] = hrow[64 * j]; hw2[j] = hrow2[64 * j]; }
            const f32x4 sa = (a0 + a1) + (a2_ + a3), sb = (b0 + b1) + (b2_ + b3);
            const float rs = rsq(((sa[0] + sa[1]) + (sa[2] + sa[3])) * (1.0f / 1024.0f) + EPS), rs2 = rsq(((sb[0] + sb[1]) + (sb[2] + sb[3])) * (1.0f / 1024.0f) + EPS);
            f32x4* orow = (f32x4*)(out + (size_t)row * 1024) + lane; f32x4* orow2 = (f32x4*)(out + (size_t)row2 * 1024) + lane;
#pragma unroll
            for (int j = 0; j < 4; ++j) { const f32x4 gv = ((const f32x4*)ln_fin)[64 * j + lane];
                f32x4 hv; hv[0] = __uint_as_float(hw[j].x << 16); hv[1] = __uint_as_float(hw[j].x & 0xffff0000u); hv[2] = __uint_as_float(hw[j].y << 16); hv[3] = __uint_as_float(hw[j].y & 0xffff0000u);
                orow[64 * j] = hv * rs * gv;
                if (row2 != row) { f32x4 hv2; hv2[0] = __uint_as_float(hw2[j].x << 16); hv2[1] = __uint_as_float(hw2[j].x & 0xffff0000u); hv2[2] = __uint_as_float(hw2[j].y << 16); hv2[3] = __uint_as_float(hw2[j].y & 0xffff0000u);
                    orow2[64 * j] = hv2 * rs2 * gv; } } }
    }
    PH_FINAL;
}
constexpr int N_PHASES = 8 + 5 * NGRP + 1 + 4;

extern "C" void kernel_launch(void* const* d_in, const int* in_sizes, int n_in, void* d_out, int out_size, void* d_ws, size_t ws_size, hipStream_t stream) {
    static int grid = 0;
    if (grid == 0) {
        if (n_in != 18 || out_size != T * D || ws_size < WS_END) { fprintf(stderr, "kernel_launch: unexpected shapes (n_in %d out %d ws %zu)\n", n_in, out_size, ws_size); grid = -1; return; }
        int dev = 0, cus = 0, per_cu = 0;
        hipGetDevice(&dev); hipDeviceGetAttribute(&cus, hipDeviceAttributeMultiprocessorCount, dev);
        hipFuncSetAttribute((const void*)mk_fwd, hipFuncAttributeMaxDynamicSharedMemorySize, LDS_BYTES);
        hipOccupancyMaxActiveBlocksPerMultiprocessor(&per_cu, (const void*)mk_fwd, 512, LDS_BYTES);
        if (per_cu < 1) { fprintf(stderr, "kernel_launch: occupancy query says %d blocks/CU\n", per_cu); grid = -1; return; }
        grid = cus;
        (void)hipGetLastError();
    }
    if (grid < 0) return;
    Args a{};
    for (int i = 0; i < 18; ++i) a.in[i] = (const float*)d_in[i];
    a.out = (float*)d_out; a.ws = (unsigned char*)d_ws; a.ph_lo = 0; a.ph_hi = N_PHASES;
    void* kargs[] = {&a};
#ifdef DBG
    for (int ph = 0; ph < N_PHASES; ++ph) { a.ph_lo = ph; a.ph_hi = ph + 1;
        hipError_t e = hipLaunchCooperativeKernel((const void*)mk_fwd, dim3(grid), dim3(512), kargs, LDS_BYTES, stream);
        if (e != hipSuccess) fprintf(stderr, "cooperative launch failed: %s (grid %d)\n", hipGetErrorString(e), grid);
        hipLaunchKernelGGL(dbg_kernel, dim3(1), dim3(512), 0, stream, a, ph); }
    hipLaunchKernelGGL(dbg_emit, dim3(1024), dim3(512), 0, stream, a);
#else
    (void)hipMemsetAsync((unsigned char*)d_ws + WS_BAR, 0, XCD_BAR_WORDS * 4, stream);
    hipError_t e = hipLaunchCooperativeKernel((const void*)mk_fwd, dim3(grid), dim3(512), kargs, LDS_BYTES, stream);
    if (e != hipSuccess) fprintf(stderr, "cooperative launch failed: %s (grid %d)\n", hipGetErrorString(e), grid);
#endif
}
```
